# Optimizing an MI355X kernel written in HIP

```python
import jax, jax.numpy as jnp
from jax import lax
import numpy as np

D_MODEL = 1024
BATCH = 4
SEQ = 8192
DEPTH = 4

GRID_W = 64
HEAD_DIM = 64
N_HEADS_A = 8
WIN_ROWS_MAX = 8
WIN_COLS = 16
WIDTH_A = N_HEADS_A * HEAD_DIM
N_HEADS_B = 4
WIDTH_B = N_HEADS_B * 2 * HEAD_DIM
Q_BLOCK = 128
D_IN_AB = 3 * WIDTH_A + 3 * WIDTH_B
D_MIX_AB = WIDTH_A + WIDTH_B
CHUNK = 128
GMLP_WIDTH = D_MODEL
GMLP_GROUPS = 8
N_EXPERTS = 16
EC_FACTOR = 2
D_EXPERT = 2 * D_MODEL
N_EVEN = (DEPTH + 1) // 2
N_ODD = DEPTH // 2
LN_EPS = 1e-5
RMS_EPS = 1e-6
DEEPNORM_ALPHA = (2.0 * DEPTH) ** 0.25
DEEPNORM_BETA = (8.0 * DEPTH) ** -0.25

kernel_name = "hybrid_natten_diffattn_gmlp_ecmoe_encoder"


def layer_norm(x, g, b):
    xf = x.astype(jnp.float32)
    mu = jnp.mean(xf, axis=-1, keepdims=True)
    var = jnp.mean(jnp.square(xf - mu), axis=-1, keepdims=True)
    y = (xf - mu) * lax.rsqrt(var + LN_EPS) * g.astype(jnp.float32) + b.astype(jnp.float32)
    return y.astype(x.dtype)


def alibi_slopes(n_heads):
    s = 2.0 ** (-8.0 * (np.arange(n_heads) + 1) / n_heads)
    return jnp.asarray(s, dtype=jnp.float32)


def lambda_init(layer_number):
    return 0.8 - 0.6 * float(np.exp(-0.3 * (layer_number - 1)))


def neighbourhood_attention(q, k, v, rpb):
    b, S, H, d = q.shape
    R = S // GRID_W
    kr = min(WIN_ROWS_MAX, R)

    def to_grid(t):
        return t.reshape(b, R, GRID_W, H, d).transpose(0, 3, 1, 2, 4)

    qg, kg, vg = to_grid(q), to_grid(k), to_grid(v)
    cols = np.arange(GRID_W)
    c_start = np.clip(cols - WIN_COLS // 2, 0, GRID_W - WIN_COLS)
    cidx = c_start[:, None] + np.arange(WIN_COLS)[None, :]
    dc = cidx - cols[:, None] + (WIN_COLS - 1)
    scale = d ** -0.5

    def row(r):
        rs = jnp.clip(r - kr // 2, 0, R - kr)
        q_r = lax.dynamic_index_in_dim(qg, r, axis=2, keepdims=False)
        k_rows = lax.dynamic_slice_in_dim(kg, rs, kr, axis=2)
        v_rows = lax.dynamic_slice_in_dim(vg, rs, kr, axis=2)
        k_nb = k_rows[:, :, :, cidx]
        v_nb = v_rows[:, :, :, cidx]
        dr = rs + jnp.arange(kr) - r + (WIN_ROWS_MAX - 1)
        bias = rpb[:, dr[:, None, None], dc[None, :, :]]
        bias = bias.transpose(0, 2, 1, 3).astype(jnp.float32)
        s = jnp.einsum('bhcd,bhicjd->bhcij', q_r, k_nb).astype(jnp.float32) * scale + bias[None]
        p = jax.nn.softmax(s.reshape(b, H, GRID_W, kr * WIN_COLS), axis=-1)
        p = p.reshape(b, H, GRID_W, kr, WIN_COLS).astype(v.dtype)
        return jnp.einsum('bhcij,bhicjd->bhcd', p, v_nb)

    out = lax.map(row, jnp.arange(R))
    return out.transpose(1, 0, 3, 2, 4).reshape(b, S, H * d)


def differential_attention(q, k, v, lam_qk, subln_g, lam_init):
    b, S, H, _, d = q.shape
    nblk = S // Q_BLOCK
    scale = d ** -0.5
    slopes = alibi_slopes(H)
    lf = lam_qk.astype(jnp.float32)
    lam = jnp.exp(jnp.sum(lf[0] * lf[1])) - jnp.exp(jnp.sum(lf[2] * lf[3])) + lam_init
    pos = jnp.arange(S)
    kt = k.transpose(0, 2, 3, 1, 4)
    vt = v.transpose(0, 2, 1, 3)
    qb = q.reshape(b, nblk, Q_BLOCK, H, 2, d).transpose(1, 0, 3, 4, 2, 5)

    def blk(args):
        q_blk, i = args
        s = jnp.einsum('bhmqd,bhmkd->bhmqk', q_blk, kt).astype(jnp.float32) * scale
        tq = i * Q_BLOCK + jnp.arange(Q_BLOCK)
        dist = jnp.abs(tq[:, None] - pos[None, :]).astype(jnp.float32)
        s = s - slopes[None, :, None, None, None] * dist[None, None, None]
        p = jax.nn.softmax(s, axis=-1)
        a = (p[:, :, 0] - lam * p[:, :, 1]).astype(v.dtype)
        return jnp.einsum('bhqk,bhkd->bhqd', a, vt)

    o = lax.map(blk, (qb, jnp.arange(nblk)))
    o = o.transpose(1, 0, 3, 2, 4).reshape(b, S, H, 2 * d)
    of = o.astype(jnp.float32)
    of = of * lax.rsqrt(jnp.mean(jnp.square(of), axis=-1, keepdims=True) + RMS_EPS)
    of = of * subln_g.astype(jnp.float32) * (1.0 - lam_init)
    return of.astype(v.dtype).reshape(b, S, H * 2 * d)


def parallel_attention_mixer(x, w_in, rpb, lam_qk, subln_g, w_out, lam_init):
    b, S, _ = x.shape
    qkv = x @ w_in
    qa, ka, va, qb, kb, vb = jnp.split(
        qkv, [WIDTH_A, 2 * WIDTH_A, 3 * WIDTH_A, 3 * WIDTH_A + WIDTH_B, 3 * WIDTH_A + 2 * WIDTH_B], axis=-1)
    sa = (b, S, N_HEADS_A, HEAD_DIM)
    sb = (b, S, N_HEADS_B, 2, HEAD_DIM)
    oa = neighbourhood_attention(qa.reshape(sa), ka.reshape(sa), va.reshape(sa), rpb)
    ob = differential_attention(qb.reshape(sb), kb.reshape(sb),
                                vb.reshape(b, S, N_HEADS_B, 2 * HEAD_DIM), lam_qk, subln_g, lam_init)
    return jnp.concatenate([oa, ob], axis=-1) @ w_out


def spatial_gating_mlp(x, w_in, ln_g, ln_b, w_s, b_s, w_out):
    b, S, _ = x.shape
    z = jax.nn.gelu(x @ w_in, approximate=False)
    u, v = jnp.split(z, 2, axis=-1)
    v = layer_norm(v, ln_g, ln_b)
    G = w_s.shape[0]
    v = v.reshape(b, S // CHUNK, CHUNK, G, GMLP_WIDTH // G)
    sv = jnp.einsum('gts,bnsgc->bntgc', w_s, v) + b_s.T[None, None, :, :, None]
    return (u * sv.reshape(b, S, GMLP_WIDTH)) @ w_out


def expert_choice_moe(x, w_router, w_gate, w_up, w_down):
    b, S, D = x.shape
    cap = EC_FACTOR * S // N_EXPERTS
    aff = jax.nn.softmax((x @ w_router).astype(jnp.float32), axis=-1)
    gate, idx = lax.top_k(aff.transpose(0, 2, 1), cap)
    bidx = jnp.arange(b)[:, None, None]
    xg = x[bidx, idx]
    h = jax.nn.silu(jnp.einsum('becd,edf->becf', xg, w_gate)) * jnp.einsum('becd,edf->becf', xg, w_up)
    y = jnp.einsum('becf,efd->becd', h, w_down) * gate[..., None].astype(x.dtype)
    return jnp.zeros_like(x).at[bidx, idx].add(y)


def setup_inputs(seed: int = 0) -> dict:
    key = jax.random.key(seed)
    ks = jax.random.split(key, 24)
    f32 = jnp.float32

    def nrm(k, shape, scale):
        return jax.random.normal(k, shape, f32) * scale

    beta = DEEPNORM_BETA
    return {
        "x": nrm(ks[0], (BATCH, SEQ, D_MODEL), 1.0),
        "w_in_ab": nrm(ks[1], (N_EVEN, D_MODEL, D_IN_AB), D_MODEL ** -0.5),
        "rpb_a": nrm(ks[2], (N_EVEN, N_HEADS_A, 2 * WIN_ROWS_MAX - 1, 2 * WIN_COLS - 1), 0.1),
        "lambda_qk": nrm(ks[3], (N_EVEN, 4, HEAD_DIM), 0.1),
        "subln_g": 1.0 + nrm(ks[4], (N_EVEN, N_HEADS_B, 2 * HEAD_DIM), 0.05),
        "w_out_ab": nrm(ks[5], (N_EVEN, D_MIX_AB, D_MODEL), beta * D_MIX_AB ** -0.5),
        "w_in_c": nrm(ks[6], (N_ODD, D_MODEL, 2 * GMLP_WIDTH), D_MODEL ** -0.5),
        "ln_v_g": 1.0 + nrm(ks[7], (N_ODD, GMLP_WIDTH), 0.05),
        "ln_v_b": nrm(ks[8], (N_ODD, GMLP_WIDTH), 0.02),
        "w_s": nrm(ks[9], (N_ODD, GMLP_GROUPS, CHUNK, CHUNK), CHUNK ** -0.5),
        "b_s": 1.0 + nrm(ks[10], (N_ODD, GMLP_GROUPS, CHUNK), 0.1),
        "w_out_c": nrm(ks[11], (N_ODD, GMLP_WIDTH, D_MODEL), beta * GMLP_WIDTH ** -0.5),
        "ln_mix_g": 1.0 + nrm(ks[12], (DEPTH, D_MODEL), 0.05),
        "ln_mix_b": nrm(ks[13], (DEPTH, D_MODEL), 0.02),
        "w_router": nrm(ks[14], (DEPTH, D_MODEL, N_EXPERTS), D_MODEL ** -0.5),
        "w_gate": nrm(ks[15], (DEPTH, N_EXPERTS, D_MODEL, D_EXPERT), D_MODEL ** -0.5),
        "w_up": nrm(ks[16], (DEPTH, N_EXPERTS, D_MODEL, D_EXPERT), D_MODEL ** -0.5),
        "w_down": nrm(ks[17], (DEPTH, N_EXPERTS, D_EXPERT, D_MODEL), beta * D_EXPERT ** -0.5),
        "ln_ffn_g": 1.0 + nrm(ks[18], (DEPTH, D_MODEL), 0.05),
        "ln_ffn_b": nrm(ks[19], (DEPTH, D_MODEL), 0.02),
    }


def reference(x, w_in_ab, rpb_a, lambda_qk, subln_g, w_out_ab, w_in_c, ln_v_g, ln_v_b, w_s, b_s,
              w_out_c, ln_mix_g, ln_mix_b, w_router, w_gate, w_up, w_down, ln_ffn_g, ln_ffn_b):
    for l in range(DEPTH):
        i = l // 2
        if l % 2 == 0:
            h = parallel_attention_mixer(x, w_in_ab[i], rpb_a[i], lambda_qk[i], subln_g[i],
                                         w_out_ab[i], lambda_init(l + 1))
        else:
            h = spatial_gating_mlp(x, w_in_c[i], ln_v_g[i], ln_v_b[i], w_s[i], b_s[i], w_out_c[i])
        x = layer_norm(DEEPNORM_ALPHA * x + h, ln_mix_g[l], ln_mix_b[l])
        h = expert_choice_moe(x, w_router[l], w_gate[l], w_up[l], w_down[l])
        x = layer_norm(DEEPNORM_ALPHA * x + h, ln_ffn_g[l], ln_ffn_b[l])
    return x
```

```cpp
#include <hip/hip_runtime.h>
#include <hip/hip_bf16.h>
#include <cstdio>
#include <cstdint>

#ifndef MK_PER_PHASE
#define MK_PER_PHASE 0
#endif

constexpr int D = 1024, BATCH = 4, SEQ = 8192, T = BATCH * SEQ, DEPTH = 4;
constexpr int NE = 16, CAP = 1024, DEXP = 2048, EROWS = BATCH * CAP;
constexpr int QKVW = 3072;
constexpr float LN_EPS = 1e-5f, RMS_EPS = 1e-6f;
constexpr float ALPHA = 1.6817928305074290f;
constexpr float LOG2E = 1.4426950408889634f;
constexpr float C2Q = 0.125f * LOG2E;
constexpr int NWAVES = 8;

constexpr size_t MiB = 1u << 20;
constexpr size_t WS_CTL = 0, CTL_ZERO_BYTES = 32 * 1024;
constexpr size_t WS_WINAB = 1 * MiB;
constexpr size_t WS_WOUTAB = WS_WINAB + 12 * MiB;
constexpr size_t WS_WINC = WS_WOUTAB + 4 * MiB;
constexpr size_t WS_WOUTC = WS_WINC + 8 * MiB;
constexpr size_t WS_WSB = WS_WOUTC + 4 * MiB;
constexpr size_t WS_AFFT = WS_WSB + 1 * MiB;
constexpr size_t WS_INV = WS_AFFT + 2 * MiB;
constexpr size_t WS_SELT = WS_INV + 2 * MiB;
constexpr size_t WS_SELG = WS_SELT + 256 * 1024;
constexpr size_t WS_WGU = 36 * MiB;
constexpr size_t WS_WD = WS_WGU + 128 * MiB;
constexpr size_t WS_XF = WS_WD + 64 * MiB;
constexpr size_t WS_XB = WS_XF + 128 * MiB;
constexpr size_t WS_QKV = WS_XB + 64 * MiB;
constexpr size_t WS_MIX = WS_QKV + 192 * MiB;
constexpr size_t WS_HM = WS_MIX + 64 * MiB;
constexpr size_t WS_HEXP = WS_HM + 64 * MiB;
constexpr size_t WS_W2 = WS_HEXP + 256 * MiB;
constexpr size_t WS_WDELTA = WS_W2 - WS_WGU;
constexpr size_t WS_END = WS_W2 + 192 * MiB;
constexpr size_t WS_KN = WS_SELG + 256 * 1024;
static_assert(WS_KN + 8192 <= WS_WGU, "ws map");

constexpr int CW_TMO = 0;
constexpr int CW_BAR = 4096;

constexpr int RING_BYTES = 133120;
constexpr int MISC_OFF = RING_BYTES;
constexpr int SCR_OFF = MISC_OFF + 1024;
constexpr int RPB_OFF = SCR_OFF + 4096;
constexpr int LDS_BYTES = RPB_OFF + 17408;
constexpr int NA_PADB = 64, NA_PEN = NA_PADB + 8 * 465 + 64;
static_assert(LDS_BYTES <= 160 * 1024, "LDS");

#define GAS __attribute__((address_space(1)))
#define LAS __attribute__((address_space(3)))
typedef unsigned short bf16_t;
typedef short bf16x8 __attribute__((ext_vector_type(8)));
typedef short s16x4 __attribute__((ext_vector_type(4)));
typedef float f32x4 __attribute__((ext_vector_type(4)));
typedef float f32x2 __attribute__((ext_vector_type(2)));
typedef float f32x16 __attribute__((ext_vector_type(16)));
typedef unsigned u32x4 __attribute__((ext_vector_type(4)));
typedef unsigned u32x2 __attribute__((ext_vector_type(2)));
#define RLX_AGENT __ATOMIC_RELAXED, __HIP_MEMORY_SCOPE_AGENT

__device__ __forceinline__ unsigned cvt_pk_bf16(float lo, float hi) { unsigned r; asm volatile("v_cvt_pk_bf16_f32 %0, %1, %2" : "=v"(r) : "v"(lo), "v"(hi)); return r; }
__device__ __forceinline__ float bf_lo(unsigned w) { return __uint_as_float(w << 16); }
__device__ __forceinline__ float bf_hi(unsigned w) { return __uint_as_float(w & 0xffff0000u); }
template <int X> __device__ __forceinline__ float swz_xor(float v) { return __builtin_bit_cast(float, __builtin_amdgcn_ds_swizzle(__builtin_bit_cast(int, v), (X << 10) | 0x1f)); }
__device__ __forceinline__ float half_sum(float v) { v += swz_xor<1>(v); v += swz_xor<2>(v); v += swz_xor<4>(v); v += swz_xor<8>(v); v += swz_xor<16>(v); return v; }
__device__ __forceinline__ float wave_max(float v) { v = fmaxf(v, swz_xor<1>(v)); v = fmaxf(v, swz_xor<2>(v)); v = fmaxf(v, swz_xor<4>(v)); v = fmaxf(v, swz_xor<8>(v)); v = fmaxf(v, swz_xor<16>(v));
    auto rr = __builtin_amdgcn_permlane32_swap(__float_as_uint(v), __float_as_uint(v), false, false); return fmaxf(__uint_as_float(rr[0]), __uint_as_float(rr[1])); }
template <int CTRL, int RM> __device__ __forceinline__ float dpp_add(float v) { return v + __builtin_bit_cast(float, __builtin_amdgcn_update_dpp(0, __builtin_bit_cast(int, v), CTRL, RM, 0xf, false)); }
__device__ __forceinline__ float wave_sum_dpp(float v) {
    v = dpp_add<0xB1, 0xf>(v); v = dpp_add<0x4E, 0xf>(v); v = dpp_add<0x141, 0xf>(v); v = dpp_add<0x140, 0xf>(v); v = dpp_add<0x142, 0xa>(v); v = dpp_add<0x143, 0xc>(v);
    return __builtin_bit_cast(float, __builtin_amdgcn_readlane(__builtin_bit_cast(int, v), 63));
}
__device__ __forceinline__ float wave_sum(float v) {
    v = half_sum(v);
    auto rr = __builtin_amdgcn_permlane32_swap(__float_as_uint(v), __float_as_uint(v), false, false); return __uint_as_float(rr[0]) + __uint_as_float(rr[1]);
}

namespace pg8 {
constexpr int BM = 256, BK = 64, HALF = 128, HTB = HALF * BK * 2, STAGE_BYTES = 8 * HTB, NXCD = 8, WGM = 8;
__host__ __device__ __forceinline__ int lds_byte(int r, int c) { const int st = (r >> 4) * 2 + (c >> 5), rr = r & 15, cc = c & 31, ob = rr * 64 + cc * 2; return st * 1024 + (ob ^ (((ob >> 9) & 1) << 5)); }
__host__ __device__ __forceinline__ void stage_rc(int b, int& R, int& C) { const int st = b / 1024, sb = b % 1024, swz = sb ^ (((sb >> 9) & 1) << 5); R = (st >> 1) * 16 + swz / 64; C = (st & 1) * 32 + (swz % 64) / 2; }
__host__ __device__ __forceinline__ int a_sw(int R) { return ((R >> 1) & 7) ^ (((R + 4) >> 3) & 1); }
__host__ __device__ __forceinline__ int a_byte(int R, int c8) { return (R >> 3) * 1024 + (R & 7) * 128 + ((c8 ^ a_sw(R)) << 4); }
__host__ __device__ __forceinline__ void a_stage_rc(int tid, int i, int& R, int& C) { const int l = tid & 63; R = 8 * ((tid >> 6) + 8 * i) + (l >> 3); C = 8 * ((l & 7) ^ a_sw(R)); }
__host__ __device__ __forceinline__ int perm32(int rho) { const int n = rho >> 4, i = rho & 15; return 8 * (i >> 2) + 4 * n + (i & 3); }

struct Unit { int pm, pn; };
struct Gemm { const bf16_t* A; const bf16_t* Bt; int M, N, K; const int* gidx; int NB; };

struct StaticOrder {
    int nM, nN, nwg, G, c;
    __device__ void init(int M, int N, int G_, int c_) { nM = M / BM; nN = N / BM; nwg = nM * nN; G = G_; c = c_; }
    __device__ bool next(int i, Unit& u) const {
        const long L = (long)i * G + c; if (L >= nwg) return false;
        int wgid = (int)L; { const int q = nwg / NXCD, r = nwg % NXCD, xcd = wgid % NXCD, off = wgid / NXCD; wgid = (xcd < r ? xcd * (q + 1) : r * (q + 1) + (xcd - r) * q) + off; }
        const int nig = WGM * nN, gid = wgid / nig, fm = gid * WGM, gsz = (nM - fm) < WGM ? (nM - fm) : WGM;
        u.pm = fm + ((wgid % nig) % gsz); u.pn = (wgid % nig) / gsz; return true;
    }
};
struct GroupedOrder {
    int mt, nt, upe, G, c, wgm, rev;
    __device__ void init(int mt_, int nt_, int G_, int c_, int wgm_ = WGM, int rev_ = 0) { mt = mt_; nt = nt_; upe = mt_ * nt_; G = G_; c = c_; wgm = wgm_; rev = rev_; }
    __device__ bool next(int i, Unit& u) const {
        const long L = (long)i * G + c; if (L >= (long)NE * upe) return false;
        const int e0 = (int)(L / upe); const int e = rev ? NE - 1 - e0 : e0; int wgid = (int)(L % upe);
        { const int q = upe / NXCD, xcd = wgid % NXCD, off = wgid / NXCD; wgid = xcd * q + off; }
        const int nig = wgm * nt, gid = wgid / nig, fm = gid * wgm, gsz = (mt - fm) < wgm ? (mt - fm) : wgm;
        u.pm = e * mt + fm + ((wgid % nig) % gsz); u.pn = e * nt + (wgid % nig) / gsz; return true;
    }
};

struct XcdExpertOrder {
    int mt, nt, G, c, rev; GroupedOrder fb;
    __device__ void init(int mt_, int nt_, int G_, int c_, int wgm_ = WGM, int rev_ = 0) { mt = mt_; nt = nt_; G = G_; c = c_; rev = rev_; fb.init(mt_, nt_, G_, c_, wgm_, rev_); }
    __device__ bool next(int i0, Unit& u) const {
        if (G != 256 || mt != 16 || (nt & 3)) return fb.next(i0, u);
        const int rpe = (mt * nt) >> 5;
        if (i0 >= 2 * rpe) return false;
        const int i = rev ? 2 * rpe - 1 - i0 : i0;
        const int x = c & 7, r = c >> 3, e = 2 * x + i / rpe, ii = i % rpe;
        u.pm = e * mt + 8 * (ii & 1) + (r >> 2); u.pn = e * nt + 4 * (ii >> 1) + (r & 3); return true;
    }
};

__device__ __forceinline__ f32x2 gelu_pk(f32x2 v) {
    const f32x2 av = __builtin_elementwise_abs(v), d = av * 0.2316418882f + 1.0f;
    f32x2 t; t.x = __builtin_amdgcn_rcpf(d.x); t.y = __builtin_amdgcn_rcpf(d.y);
    f32x2 q = t * 0.5307027145f + (-0.7265760135f); q = q * t + 0.7107068705f; q = q * t + (-0.142248368f); q = q * t + 0.127414796f; q = q * t;
    const f32x2 s = (v * v) * (-0.72134752044f);
    f32x2 e; e.x = __builtin_amdgcn_exp2f(s.x); e.y = __builtin_amdgcn_exp2f(s.y);
    const f32x2 m = v * (q * e), r = v - m;
    f32x2 o; o.x = v.x < 0.f ? m.x : r.x; o.y = v.y < 0.f ? m.y : r.y; return o;
}
__device__ __forceinline__ float silu_f(float g) { return g * __builtin_amdgcn_rcpf(1.0f + __builtin_amdgcn_exp2f(-g * LOG2E)); }

template <int MODE> struct EpiBf16 {
    static constexpr bool PERM = true, ROWSCALE = false;
    bf16_t* O; int ldc;
    __device__ __forceinline__ void operator()(const f32x4 (&acc)[2][2][4][2], const Unit& u, int wr, int wc, int fr, int fq) const {
        const int row0 = u.pm * BM + wr * 64 + fr; const int col0 = u.pn * BM + wc * 32 + 8 * fq;
        float sc = 1.f; if (MODE == 2) { if (u.pn < 2 || u.pn == 6 || u.pn == 7) sc = C2Q; }
#pragma unroll
        for (int ai = 0; ai < 2; ++ai)
#pragma unroll
            for (int m = 0; m < 4; ++m) { bf16_t* rowp = O + (size_t)(row0 + ai * HALF + m * 16) * ldc + col0;
#pragma unroll
                for (int bj = 0; bj < 2; ++bj) { f32x4 v0 = acc[ai][bj][m][0], v1 = acc[ai][bj][m][1];
                    if (MODE == 1) { f32x2 a = gelu_pk((f32x2){v0[0], v0[1]}), b = gelu_pk((f32x2){v0[2], v0[3]}), c = gelu_pk((f32x2){v1[0], v1[1]}), d = gelu_pk((f32x2){v1[2], v1[3]});
                        v0 = (f32x4){a.x, a.y, b.x, b.y}; v1 = (f32x4){c.x, c.y, d.x, d.y}; }
                    if (MODE == 2) { v0 = v0 * sc; v1 = v1 * sc; }
                    u32x4 w; w.x = cvt_pk_bf16(v0[0], v0[1]); w.y = cvt_pk_bf16(v0[2], v0[3]); w.z = cvt_pk_bf16(v1[0], v1[1]); w.w = cvt_pk_bf16(v1[2], v1[3]);
                    *(u32x4*)(rowp + bj * HALF) = w; } }
    }
};
struct EpiSwiGLU {
    static constexpr bool PERM = true, ROWSCALE = false;
    bf16_t* H;
    __device__ __forceinline__ void operator()(const f32x4 (&acc)[2][2][4][2], const Unit& u, int wr, int wc, int fr, int fq) const {
        char* base = (char*)H + ((size_t)(u.pm * 2) * 32 + (size_t)((u.pn & 15) * 2 + (wc >> 1))) * 16384;
        const unsigned loff = (unsigned)a_byte(wr * 64 + fr, (wc & 1) * 4 + fq);
#pragma unroll
        for (int ai = 0; ai < 2; ++ai)
#pragma unroll
            for (int m = 0; m < 4; ++m) {
                const f32x4 g0 = acc[ai][0][m][0], g1 = acc[ai][0][m][1], u0 = acc[ai][1][m][0], u1 = acc[ai][1][m][1];
                u32x4 w; w.x = cvt_pk_bf16(silu_f(g0[0]) * u0[0], silu_f(g0[1]) * u0[1]); w.y = cvt_pk_bf16(silu_f(g0[2]) * u0[2], silu_f(g0[3]) * u0[3]);
                w.z = cvt_pk_bf16(silu_f(g1[0]) * u1[0], silu_f(g1[1]) * u1[1]); w.w = cvt_pk_bf16(silu_f(g1[2]) * u1[2], silu_f(g1[3]) * u1[3]);
                *(u32x4*)(base + (size_t)(loff + (unsigned)(ai * 32 * 16384 + m * 2048))) = w; }
    }
};
struct EpiDown {
    static constexpr bool PERM = true, ROWSCALE = true;
    bf16_t* Y; const float* gate;
    __device__ __forceinline__ void operator()(const f32x4 (&acc)[2][2][4][2], const Unit& u, int wr, int wc, int fr, int fq, const LAS float* rs) const {
        const int row0 = u.pm * BM + wr * 64 + fr; const int col0 = (u.pn & 3) * BM + wc * 32 + 8 * fq;
#pragma unroll
        for (int ai = 0; ai < 2; ++ai)
#pragma unroll
            for (int m = 0; m < 4; ++m) { const int row = row0 + ai * HALF + m * 16; const float gv = rs[wr * 64 + fr + ai * HALF + m * 16]; bf16_t* rowp = Y + (size_t)row * D + col0;
#pragma unroll
                for (int bj = 0; bj < 2; ++bj) { const f32x4 v0 = acc[ai][bj][m][0] * gv, v1 = acc[ai][bj][m][1] * gv;
                    u32x4 w; w.x = cvt_pk_bf16(v0[0], v0[1]); w.y = cvt_pk_bf16(v0[2], v0[3]); w.z = cvt_pk_bf16(v1[0], v1[1]); w.w = cvt_pk_bf16(v1[2], v1[3]);
                    *(u32x4*)(rowp + bj * HALF) = w; } }
    }
};

template <class Epi, class Sched, bool GATHER, bool AIMG = false>
__device__ __forceinline__ void gemm_phase(LAS unsigned char* lds, const Gemm g, const Sched& S, const Epi& E, const int tid) {
    const int wid = __builtin_amdgcn_readfirstlane(tid >> 6), lane = tid & 63, wr = wid >> 2, wc = wid & 3, fr = lane & 15, fq = lane >> 4;
    const int K = g.K, nt = K / BK;
    unsigned voffA[2], voffB[2];
#pragma unroll
    for (int i = 0; i < 2; ++i) { int R, C; a_stage_rc(tid, i, R, C);
        static_assert(Epi::PERM, "the image-ordered B storage carries the PERM row permutation");
        voffA[i] = AIMG ? (unsigned)(tid * 16 + i * 8192) : (unsigned)(R * K + C) * 2u; voffB[i] = (unsigned)(tid * 16 + i * 8192); }
#define PG8_GOFF(pm_, o00, o01, o10, o11) do { const int* _gi = g.gidx + (pm_) * BM; int _R0, _C0, _R1, _C1; a_stage_rc(tid, 0, _R0, _C0); a_stage_rc(tid, 1, _R1, _C1); \
        o00 = ((unsigned)_gi[_R0] * (unsigned)K + (unsigned)_C0) * 2u; o01 = ((unsigned)_gi[_R1] * (unsigned)K + (unsigned)_C1) * 2u; \
        o10 = ((unsigned)_gi[HALF + _R0] * (unsigned)K + (unsigned)_C0) * 2u; o11 = ((unsigned)_gi[HALF + _R1] * (unsigned)K + (unsigned)_C1) * 2u; } while (0)
    const size_t kstep = (size_t)(BK * 2);
    const size_t hstep = (size_t)HALF * K * 2;
    const size_t tstep = 2 * hstep;
    const size_t kstepB = 16384, hstepB = hstep, kstepA = AIMG ? (size_t)16384 : kstep;
#define PG8_BBASE(pn_) ((const char*)g.Bt + (size_t)(pn_) * tstep)
    const unsigned ldsw = (unsigned)wid * 1024u;
    const int aoffk[2] = {a_byte(wr * 64 + fr, fq), a_byte(wr * 64 + fr, fq + 4)}; const int boff = lds_byte(wc * 32 + fr, fq * 8);
#define PG8_SA(b, h) (((b) * 2 + (h)) * HTB)
#define PG8_SB(b, h) ((4 + (b) * 2 + (h)) * HTB)
#define PG8_STAGE(bufoff, gbase, voff) do { _Pragma("unroll") for (int _i = 0; _i < 2; ++_i) \
        __builtin_amdgcn_global_load_lds((const unsigned*)((const char*)(gbase) + (voff)[_i]), (LAS unsigned*)(lds + (bufoff) + ldsw + _i * 8192), 16, 0, 0); } while (0)
#define PG8_STAGE2(bufoff, gbase, o0, o1) do { \
        __builtin_amdgcn_global_load_lds((const unsigned*)((const char*)(gbase) + (o0)), (LAS unsigned*)(lds + (bufoff) + ldsw), 16, 0, 0); \
        __builtin_amdgcn_global_load_lds((const unsigned*)((const char*)(gbase) + (o1)), (LAS unsigned*)(lds + (bufoff) + ldsw + 8192), 16, 0, 0); } while (0)
#define PG8_LDA(dst, b, h) do { _Pragma("unroll") for (int m = 0; m < 4; ++m) _Pragma("unroll") for (int k = 0; k < 2; ++k) dst[m][k] = *(const LAS bf16x8*)(lds + PG8_SA(b, h) + aoffk[k] + m * 2048); } while (0)
#define PG8_LDB(dst, b, h) do { _Pragma("unroll") for (int n = 0; n < 2; ++n) _Pragma("unroll") for (int k = 0; k < 2; ++k) dst[n][k] = *(const LAS bf16x8*)(lds + PG8_SB(b, h) + boff + n * 2048 + k * 1024); } while (0)
#define PG8_MMA(ai, bj, At, Bt) do { __builtin_amdgcn_s_setprio(1); _Pragma("unroll") for (int m = 0; m < 4; ++m) _Pragma("unroll") for (int n = 0; n < 2; ++n) _Pragma("unroll") for (int k = 0; k < 2; ++k) \
        acc[ai][bj][m][n] = __builtin_amdgcn_mfma_f32_16x16x32_bf16(Bt[n][k], At[m][k], acc[ai][bj][m][n], 0, 0, 0); __builtin_amdgcn_s_setprio(0); } while (0)
#define PG8_WAIT_V(n) asm volatile("s_waitcnt vmcnt(" #n ")" ::: "memory")
#define PG8_WAIT_L(n) asm volatile("s_waitcnt lgkmcnt(" #n ")" ::: "memory")
#define PG8_BAR __builtin_amdgcn_s_barrier()
#define PG8_SCHED __builtin_amdgcn_sched_barrier(0)
#define PG8_STA(bufoff, kt, h, NXT) do { if constexpr (GATHER) { const char* _b = (const char*)g.A + (size_t)(kt) * kstep; \
            if ((h) == 0) PG8_STAGE2(bufoff, _b, gc00, gc01); else PG8_STAGE2(bufoff, _b, gc10, gc11); } \
        else { const char* _b = ((NXT) ? nA : cA) + (size_t)(kt) * kstepA + (size_t)(h) * hstep; PG8_STAGE(bufoff, _b, voffA); } } while (0)
    Unit cur, nxt; int ui = 0;
    if (!S.next(0, cur)) return;
    f32x4 acc[2][2][4][2];
#pragma unroll
    for (int a = 0; a < 2; ++a)
#pragma unroll
        for (int b = 0; b < 2; ++b)
#pragma unroll
            for (int m = 0; m < 4; ++m)
#pragma unroll
                for (int n = 0; n < 2; ++n) acc[a][b][m][n] = (f32x4){0.f, 0.f, 0.f, 0.f};
    bf16x8 At[4][2], B0[2][2], B1[2][2];
    const char* cA = (const char*)g.A + (size_t)cur.pm * tstep; const char* cB = PG8_BBASE(cur.pn);
    const char* nA = cA;
    unsigned gc00 = 0, gc01 = 0, gc10 = 0, gc11 = 0;
    if constexpr (GATHER) { PG8_GOFF(cur.pm, gc00, gc01, gc10, gc11); }
    PG8_STAGE(PG8_SB(0, 0), cB, voffB); PG8_STAGE(PG8_SB(0, 1), cB + hstepB, voffB); PG8_STA(PG8_SA(0, 0), 0, 0, false); PG8_STA(PG8_SA(0, 1), 0, 1, false);
    if (wr == 1) PG8_BAR;
    PG8_WAIT_V(2); PG8_BAR;
    PG8_STAGE(PG8_SB(1, 0), cB + kstepB, voffB); PG8_STA(PG8_SA(1, 0), 1, 0, false); PG8_STAGE(PG8_SB(1, 1), cB + hstepB + kstepB, voffB);
    PG8_WAIT_V(6); PG8_BAR;
    for (;;) {
        const bool has_next = S.next(ui + 1, nxt);
        nA = has_next ? (const char*)g.A + (size_t)nxt.pm * tstep : cA; const char* nB = has_next ? PG8_BBASE(nxt.pn) : cB;
        if constexpr (GATHER) { if (has_next && wid == 0) __builtin_amdgcn_global_load_lds((const unsigned*)(g.gidx + nxt.pm * BM) + lane * 4, (LAS unsigned*)(lds + STAGE_BYTES), 16, 0, 0); }
        if constexpr (Epi::ROWSCALE) { if (wid == 0) __builtin_amdgcn_global_load_lds((const unsigned*)(E.gate + cur.pm * BM) + lane * 4, (LAS unsigned*)(lds + STAGE_BYTES + (ui & 1) * 1024), 16, 0, 0); }
        for (int t = 0; t < nt; t += 2) {
            const bool last = (t == nt - 2);

            const int k2 = last ? 0 : t + 2, k3 = k2 + 1;
            const char* b2 = last ? nB : cB + (size_t)(t + 2) * kstepB; const char* b3 = b2 + kstepB;
            PG8_LDB(B0, 0, 0); PG8_LDB(B1, 0, 1); PG8_SCHED; PG8_LDA(At, 0, 0); PG8_STA(PG8_SA(1, 1), t + 1, 1, false);
            PG8_WAIT_V(8); PG8_WAIT_L(0); PG8_BAR; PG8_MMA(0, 0, At, B0); PG8_MMA(0, 1, At, B1); PG8_BAR; PG8_SCHED;
            if constexpr (GATHER) { if (last && has_next) { const LAS int* _li = (const LAS int*)(lds + STAGE_BYTES); int _R0, _C0, _R1, _C1; a_stage_rc(tid, 0, _R0, _C0); a_stage_rc(tid, 1, _R1, _C1);
                gc00 = ((unsigned)_li[_R0] * (unsigned)K + (unsigned)_C0) * 2u; gc01 = ((unsigned)_li[_R1] * (unsigned)K + (unsigned)_C1) * 2u;
                gc10 = ((unsigned)_li[HALF + _R0] * (unsigned)K + (unsigned)_C0) * 2u; gc11 = ((unsigned)_li[HALF + _R1] * (unsigned)K + (unsigned)_C1) * 2u; } }
            PG8_LDA(At, 0, 1); PG8_STAGE(PG8_SB(0, 0), b2, voffB); PG8_STAGE(PG8_SB(0, 1), b2 + hstepB, voffB); if (last) PG8_STA(PG8_SA(0, 0), k2, 0, true); else PG8_STA(PG8_SA(0, 0), k2, 0, false);
            PG8_WAIT_V(8); PG8_WAIT_L(0); PG8_BAR; PG8_MMA(1, 0, At, B0); PG8_MMA(1, 1, At, B1); PG8_BAR; PG8_SCHED;
            PG8_LDB(B0, 1, 0); PG8_LDB(B1, 1, 1); PG8_SCHED; PG8_LDA(At, 1, 0); if (last) PG8_STA(PG8_SA(0, 1), k2, 1, true); else PG8_STA(PG8_SA(0, 1), k2, 1, false);
            PG8_WAIT_V(8); PG8_WAIT_L(0); PG8_BAR; PG8_MMA(0, 0, At, B0); PG8_MMA(0, 1, At, B1); PG8_BAR; PG8_SCHED;
            PG8_LDA(At, 1, 1); PG8_STAGE(PG8_SB(1, 0), b3, voffB); PG8_STAGE(PG8_SB(1, 1), b3 + hstepB, voffB); if (last) PG8_STA(PG8_SA(1, 0), k3, 0, true); else PG8_STA(PG8_SA(1, 0), k3, 0, false);
            PG8_WAIT_V(8); PG8_WAIT_L(0); PG8_BAR; PG8_MMA(1, 0, At, B0); PG8_MMA(1, 1, At, B1); PG8_BAR; PG8_SCHED;
        }
        if (wr == 0) PG8_BAR;
        if constexpr (Epi::ROWSCALE) E(acc, cur, wr, wc, fr, fq, (const LAS float*)(lds + STAGE_BYTES + (ui & 1) * 1024)); else E(acc, cur, wr, wc, fr, fq);
        if (!has_next) break;
#pragma unroll
        for (int a = 0; a < 2; ++a)
#pragma unroll
            for (int b = 0; b < 2; ++b)
#pragma unroll
                for (int m = 0; m < 4; ++m)
#pragma unroll
                    for (int n = 0; n < 2; ++n) acc[a][b][m][n] = (f32x4){0.f, 0.f, 0.f, 0.f};
        cur = nxt; cA = nA; cB = nB; ++ui;
        if (wr == 1) PG8_BAR;
    }
    PG8_WAIT_V(0);
    PG8_BAR;
#undef PG8_BBASE
#undef PG8_SA
#undef PG8_SB
#undef PG8_STAGE
#undef PG8_STAGE2
#undef PG8_STA
#undef PG8_GOFF
#undef PG8_LDA
#undef PG8_LDB
#undef PG8_MMA
#undef PG8_WAIT_V
#undef PG8_WAIT_L
#undef PG8_BAR
#undef PG8_SCHED
}
}

#define XB_TMO      128
#define XB_XCNT(j)  (256  + 64 * (j))
#define XB_XSUB(j)  (1280 + 64 * (j))
#define XB_XGEN(j)  (2304 + 64 * (j))
#define XB_TOP      3328
#define XB_TOPGEN   3392
#define XCD_BAR_WORDS 3456
#define XB_SPIN_CAP (1u << 22)
__device__ __forceinline__ unsigned xb_ld(unsigned* p)              { return __hip_atomic_load(p, __ATOMIC_RELAXED, __HIP_MEMORY_SCOPE_AGENT); }
__device__ __forceinline__ unsigned xb_add(unsigned* p, unsigned v) { return __hip_atomic_fetch_add(p, v, __ATOMIC_RELAXED, __HIP_MEMORY_SCOPE_AGENT); }
__device__ __forceinline__ unsigned xb_xcc_id() { return (unsigned)__builtin_amdgcn_s_getreg((3 << 11) | 20) & 0xFu; }
#define XB_SPIN(cond, bar) do { unsigned _sp = 0; while (cond) { __builtin_amdgcn_s_sleep(1); \
    if ((++_sp & 255u) == 0u) { if (xb_ld(&(bar)[XB_TMO])) break; if (_sp > XB_SPIN_CAP) { atomicAdd(&(bar)[XB_TMO], 1u); break; } } } } while (0)
struct XcdBarrier { unsigned* bar; unsigned x; volatile LAS unsigned* st; };
__device__ __forceinline__ XcdBarrier xcd_barrier_post(unsigned* bar, volatile LAS unsigned* st) {
    XcdBarrier b; b.bar = bar; b.x = xb_xcc_id(); b.st = st;
    if (threadIdx.x == 0) (void)xb_add(&bar[XB_XCNT(b.x)], 1u);
    return b;
}
__device__ __forceinline__ void xcd_barrier_complete(unsigned* bar, unsigned x, unsigned& nloc, unsigned& nx) {
    const unsigned G = gridDim.x * gridDim.y * gridDim.z;
    unsigned sum, cnt, mine, sp = 0u;
    for (;;) {
        sum = 0u; cnt = 0u; mine = 0u;
#pragma unroll
        for (unsigned j = 0; j < 16; ++j) { const unsigned c = xb_ld(&bar[XB_XCNT(j)]); sum += c; cnt += (c > 0u) ? 1u : 0u; mine = (j == x) ? c : mine; }
        if (sum == G) break;
        __builtin_amdgcn_s_sleep(1);
        if ((++sp & 255u) == 0u) { if (xb_ld(&bar[XB_TMO])) break; if (sp > XB_SPIN_CAP) { atomicAdd(&bar[XB_TMO], 1u); break; } }
    }
    nloc = mine > 0u ? mine : 1u; nx = cnt > 0u ? cnt : 1u;
}
__device__ __forceinline__ void xcd_barrier(const XcdBarrier& b) {
    asm volatile("s_waitcnt vmcnt(0)" ::: "memory");
    __syncthreads();
    if (threadIdx.x == 0) {
        unsigned* bar = b.bar;
        __builtin_amdgcn_s_waitcnt(0);
        unsigned nloc = b.st[0], nx = b.st[1];
        if (nloc == 0u) { xcd_barrier_complete(bar, b.x, nloc, nx); b.st[0] = nloc; b.st[1] = nx; }
        const unsigned old = xb_add(&bar[XB_XSUB(b.x)], 1u);
        const unsigned gen = old / nloc;
        if (old + 1u == (gen + 1u) * nloc) {
            __builtin_amdgcn_fence(__ATOMIC_RELEASE, "agent");
            asm volatile("s_waitcnt vmcnt(0)" ::: "memory");
            const unsigned og = xb_add(&bar[XB_TOP], 1u);
            const unsigned tg = og / nx;
            if (og + 1u == (tg + 1u) * nx) xb_add(&bar[XB_TOPGEN], 1u);
            else XB_SPIN(xb_ld(&bar[XB_TOPGEN]) == tg, bar);
            __builtin_amdgcn_fence(__ATOMIC_ACQUIRE, "agent");
            xb_add(&bar[XB_XGEN(b.x)], 1u);
            asm volatile("s_waitcnt vmcnt(0)" ::: "memory");
        } else {
            XB_SPIN(xb_ld(&bar[XB_XGEN(b.x)]) == gen, bar);
            __builtin_amdgcn_fence(__ATOMIC_ACQUIRE, "agent");
            asm volatile("s_waitcnt vmcnt(0)" ::: "memory");
        }
    }
    __syncthreads();
}

#define LDS_WAIT() asm volatile("s_waitcnt lgkmcnt(0)" ::: "memory")
#define VM_WAIT() asm volatile("s_waitcnt vmcnt(0)" ::: "memory")
#define SBAR() __builtin_amdgcn_sched_barrier(0)
__device__ __forceinline__ float uni_f(float v) { return __builtin_bit_cast(float, __builtin_amdgcn_readfirstlane(__builtin_bit_cast(int, v))); }
__device__ __forceinline__ int crow(int r, int hi) { return (r & 3) + 8 * (r >> 2) + 4 * hi; }
__device__ __forceinline__ void glds16(const void* gsrc, unsigned lds_dst) { unsigned keep;
    asm volatile("s_mov_b32 %0, m0\n\ts_mov_b32 m0, %2\n\ts_nop 0\n\tglobal_load_lds_dwordx4 %1, off\n\ts_mov_b32 m0, %0" : "=&s"(keep) : "v"(gsrc), "s"(lds_dst) : "memory"); }
typedef LAS const char* lds_cptr;
typedef short v4i16_t __attribute__((ext_vector_type(4)));
__device__ __forceinline__ s16x4 vtr(lds_cptr p) { return __builtin_bit_cast(s16x4, __builtin_amdgcn_ds_read_tr16_b64_v4i16((LAS v4i16_t*)p)); }
__device__ __forceinline__ float pl32_max(float m) { auto rr = __builtin_amdgcn_permlane32_swap(__float_as_uint(m), __float_as_uint(m), false, false); return fmaxf(__uint_as_float(rr[0]), __uint_as_float(rr[1])); }
__device__ __forceinline__ float pl32_sum(float m) { auto rr = __builtin_amdgcn_permlane32_swap(__float_as_uint(m), __float_as_uint(m), false, false); return __uint_as_float(rr[0]) + __uint_as_float(rr[1]); }

#define LDS_RD128(dst, addr, off) asm volatile("ds_read_b128 %0, %1 offset:%c2" : "=&v"(dst) : "v"(addr), "i"(off) : "memory")
#define LDS_TR64(dst, addr, off) asm volatile("ds_read_b64_tr_b16 %0, %1 offset:%c2" : "=&v"(dst) : "v"(addr), "i"(off) : "memory")
__device__ __forceinline__ const char* uni_ptr(const void* p) { const unsigned long long u = (unsigned long long)p;
    const unsigned lo = (unsigned)__builtin_amdgcn_readfirstlane((int)(unsigned)u), hi = (unsigned)__builtin_amdgcn_readfirstlane((int)(unsigned)(u >> 32)); return (const char*)(((unsigned long long)hi << 32) | lo); }
__device__ __forceinline__ void glds16s(const void* sbase, unsigned voff, unsigned lds_dst) { unsigned keep;
    asm volatile("s_mov_b32 %0, m0\n\ts_mov_b32 m0, %3\n\ts_nop 0\n\tglobal_load_lds_dwordx4 %1, %2\n\ts_mov_b32 m0, %0" : "=&s"(keep) : "v"(voff), "s"(sbase), "s"(lds_dst) : "memory"); }
__device__ __forceinline__ void qkt_asm(f32x16& p0, f32x16& p1, unsigned ka, const bf16x8* qr, const f32x16& cinit) {
    bf16x8 k0, k1, k2, k3, k4, k5, k6, k7;
    asm volatile("s_waitcnt lgkmcnt(0)" ::: "memory");
    LDS_RD128(k0, ka, 0); LDS_RD128(k1, ka, 512); LDS_RD128(k2, ka, 2048); LDS_RD128(k3, ka, 2560);
    asm volatile("s_waitcnt lgkmcnt(2)" : "+v"(k0), "+v"(k1));
    p0 = __builtin_amdgcn_mfma_f32_32x32x16_bf16(k0, qr[0], cinit, 0, 0, 0); p1 = __builtin_amdgcn_mfma_f32_32x32x16_bf16(k1, qr[0], cinit, 0, 0, 0);
    asm volatile("" : "+v"(p0), "+v"(p1));
    LDS_RD128(k4, ka, 4096); LDS_RD128(k5, ka, 4608);
    asm volatile("s_waitcnt lgkmcnt(2)" : "+v"(k2), "+v"(k3));
    p0 = __builtin_amdgcn_mfma_f32_32x32x16_bf16(k2, qr[1], p0, 0, 0, 0); p1 = __builtin_amdgcn_mfma_f32_32x32x16_bf16(k3, qr[1], p1, 0, 0, 0);
    asm volatile("" : "+v"(p0), "+v"(p1));
    LDS_RD128(k6, ka, 6144); LDS_RD128(k7, ka, 6656);
    asm volatile("s_waitcnt lgkmcnt(2)" : "+v"(k4), "+v"(k5));
    p0 = __builtin_amdgcn_mfma_f32_32x32x16_bf16(k4, qr[2], p0, 0, 0, 0); p1 = __builtin_amdgcn_mfma_f32_32x32x16_bf16(k5, qr[2], p1, 0, 0, 0);
    asm volatile("s_waitcnt lgkmcnt(0)" : "+v"(k6), "+v"(k7));
    p0 = __builtin_amdgcn_mfma_f32_32x32x16_bf16(k6, qr[3], p0, 0, 0, 0); p1 = __builtin_amdgcn_mfma_f32_32x32x16_bf16(k7, qr[3], p1, 0, 0, 0);
}
__device__ __forceinline__ void qkt_na(f32x16& p0, f32x16& p1, const unsigned (&ka)[4], const bf16x8* qr, const f32x16& cinit) {
    bf16x8 k0, k1, k2, k3, k4, k5, k6, k7;
    asm volatile("s_waitcnt lgkmcnt(0)" ::: "memory");
    LDS_RD128(k0, ka[0], 0); LDS_RD128(k1, ka[0], 4096); LDS_RD128(k2, ka[1], 0); LDS_RD128(k3, ka[1], 4096);
    asm volatile("s_waitcnt lgkmcnt(2)" : "+v"(k0), "+v"(k1));
    p0 = __builtin_amdgcn_mfma_f32_32x32x16_bf16(k0, qr[0], cinit, 0, 0, 0); p1 = __builtin_amdgcn_mfma_f32_32x32x16_bf16(k1, qr[0], cinit, 0, 0, 0);
    asm volatile("" : "+v"(p0), "+v"(p1));
    LDS_RD128(k4, ka[2], 0); LDS_RD128(k5, ka[2], 4096);
    asm volatile("s_waitcnt lgkmcnt(2)" : "+v"(k2), "+v"(k3));
    p0 = __builtin_amdgcn_mfma_f32_32x32x16_bf16(k2, qr[1], p0, 0, 0, 0); p1 = __builtin_amdgcn_mfma_f32_32x32x16_bf16(k3, qr[1], p1, 0, 0, 0);
    asm volatile("" : "+v"(p0), "+v"(p1));
    LDS_RD128(k6, ka[3], 0); LDS_RD128(k7, ka[3], 4096);
    asm volatile("s_waitcnt lgkmcnt(2)" : "+v"(k4), "+v"(k5));
    p0 = __builtin_amdgcn_mfma_f32_32x32x16_bf16(k4, qr[2], p0, 0, 0, 0); p1 = __builtin_amdgcn_mfma_f32_32x32x16_bf16(k5, qr[2], p1, 0, 0, 0);
    asm volatile("s_waitcnt lgkmcnt(0)" : "+v"(k6), "+v"(k7));
    p0 = __builtin_amdgcn_mfma_f32_32x32x16_bf16(k6, qr[3], p0, 0, 0, 0); p1 = __builtin_amdgcn_mfma_f32_32x32x16_bf16(k7, qr[3], p1, 0, 0, 0);
}
#define PV_RD(L, H, D0) do { LDS_TR64(L##0, va, (D0) * 4096); LDS_TR64(H##0, va, (D0) * 4096 + 512); LDS_TR64(L##1, va, (D0) * 4096 + 1024); LDS_TR64(H##1, va, (D0) * 4096 + 1536); \
        LDS_TR64(L##2, va, (D0) * 4096 + 2048); LDS_TR64(H##2, va, (D0) * 4096 + 2560); LDS_TR64(L##3, va, (D0) * 4096 + 3072); LDS_TR64(H##3, va, (D0) * 4096 + 3584); } while (0)
#define PV_PK(L, H) (bf16x8){L[0], L[1], L[2], L[3], H[0], H[1], H[2], H[3]}
#define PV_MM(L, H, D0) do { o[D0] = __builtin_amdgcn_mfma_f32_32x32x16_bf16(a0, PV_PK(L##0, H##0), o[D0], 0, 0, 0); o[D0] = __builtin_amdgcn_mfma_f32_32x32x16_bf16(a1, PV_PK(L##1, H##1), o[D0], 0, 0, 0); \
        o[D0] = __builtin_amdgcn_mfma_f32_32x32x16_bf16(a2, PV_PK(L##2, H##2), o[D0], 0, 0, 0); o[D0] = __builtin_amdgcn_mfma_f32_32x32x16_bf16(a3, PV_PK(L##3, H##3), o[D0], 0, 0, 0); } while (0)
#define PV_WAIT(N, L, H) asm volatile("s_waitcnt lgkmcnt(" #N ")" : "+v"(L##0), "+v"(H##0), "+v"(L##1), "+v"(H##1), "+v"(L##2), "+v"(H##2), "+v"(L##3), "+v"(H##3))
template <int NQ> __device__ __forceinline__ void pv_asm(f32x16* o, unsigned va, bf16x8 a0, bf16x8 a1, bf16x8 a2, bf16x8 a3) {
    s16x4 xl0, xl1, xl2, xl3, xh0, xh1, xh2, xh3, yl0, yl1, yl2, yl3, yh0, yh1, yh2, yh3;
    asm volatile("s_waitcnt lgkmcnt(0)" ::: "memory");
    PV_RD(xl, xh, 0);
    if (NQ == 2) { PV_RD(yl, yh, 1); PV_WAIT(8, xl, xh); PV_MM(xl, xh, 0); PV_WAIT(0, yl, yh); PV_MM(yl, yh, 1); }
    else { PV_RD(yl, yh, 1); PV_WAIT(8, xl, xh); PV_MM(xl, xh, 0); PV_RD(xl, xh, 2); PV_WAIT(8, yl, yh); PV_MM(yl, yh, 1); PV_RD(yl, yh, 3); PV_WAIT(8, xl, xh); PV_MM(xl, xh, 2); PV_WAIT(0, yl, yh); PV_MM(yl, yh, 3); }
}

struct ImItem { const char* src; char* dst; unsigned ldw4; };
#define IM_LOAD(V, I, lo4) do { _Pragma("unroll") for (int k_ = 0; k_ < 32; ++k_) V[k_] = *(const float*)((I).src + (size_t)((unsigned)k_ * (I).ldw4 + (lo4))); } while (0)
#define IM_STORE(V, I, scr, wofs, swz, lane16) do { _Pragma("unroll") for (int c_ = 0; c_ < 4; ++c_) { u32x4 o_; o_.x = cvt_pk_bf16(V[c_ * 8 + 0], V[c_ * 8 + 1]); o_.y = cvt_pk_bf16(V[c_ * 8 + 2], V[c_ * 8 + 3]); \
            o_.z = cvt_pk_bf16(V[c_ * 8 + 4], V[c_ * 8 + 5]); o_.w = cvt_pk_bf16(V[c_ * 8 + 6], V[c_ * 8 + 7]); *(LAS u32x4*)((scr) + (wofs) + (((unsigned)c_ * 16u) ^ (swz))) = o_; } \
        _Pragma("unroll") for (int s_ = 0; s_ < 4; ++s_) { const u32x4 o_ = *(const LAS u32x4*)((scr) + s_ * 1024 + (lane16)); *(u32x4*)((I).dst + (size_t)((unsigned)s_ * 2048u + (lane16))) = o_; } } while (0)
#define IM_LOAD_NT(V, I, lo4) do { _Pragma("unroll") for (int k_ = 0; k_ < 32; ++k_) V[k_] = __builtin_nontemporal_load((const float*)((I).src + (size_t)((unsigned)k_ * (I).ldw4 + (lo4)))); } while (0)
#define IM_STORE_NT(V, I, scr, wofs, swz, lane16) do { _Pragma("unroll") for (int c_ = 0; c_ < 4; ++c_) { u32x4 o_; o_.x = cvt_pk_bf16(V[c_ * 8 + 0], V[c_ * 8 + 1]); o_.y = cvt_pk_bf16(V[c_ * 8 + 2], V[c_ * 8 + 3]); \
            o_.z = cvt_pk_bf16(V[c_ * 8 + 4], V[c_ * 8 + 5]); o_.w = cvt_pk_bf16(V[c_ * 8 + 6], V[c_ * 8 + 7]); *(LAS u32x4*)((scr) + (wofs) + (((unsigned)c_ * 16u) ^ (swz))) = o_; } \
        _Pragma("unroll") for (int s_ = 0; s_ < 4; ++s_) { const u32x4 o_ = *(const LAS u32x4*)((scr) + s_ * 1024 + (lane16)); __builtin_nontemporal_store(o_, (u32x4*)((I).dst + (size_t)((unsigned)s_ * 2048u + (lane16)))); } } while (0)
__device__ __forceinline__ void im_lane(int lane, unsigned& wofs, unsigned& swz) {
    const unsigned pos = (unsigned)((lane & 32) | (((lane >> 2) & 1) << 4) | (((lane >> 3) & 3) << 2) | (lane & 3)); wofs = (pos >> 4) * 1024u + (pos & 15u) * 64u; swz = (pos & 8u) << 2; }
__device__ __forceinline__ ImItem im_dense_item(const float* W, int N, int K, bf16_t* WT, int kh, int nb) {
    ImItem I; I.src = (const char*)(W + (size_t)(32 * kh) * N + 64 * nb); I.ldw4 = (unsigned)N * 4u;
    I.dst = (char*)WT + ((size_t)(nb >> 1) * (K / 64) + (kh >> 1)) * 16384 + (size_t)(((nb & 1) * 4) * 2 + (kh & 1)) * 1024; return I; }

struct Args { const float* in[20]; float* out; unsigned char* ws; int ph_lo, ph_hi; };
static_assert(sizeof(Args) == 22 * 8 + 8, "no padding");
typedef const __attribute__((address_space(4))) Args* KArgs;
enum { I_X = 0, I_WINAB, I_RPB, I_LAMQK, I_SUBLN, I_WOUTAB, I_WINC, I_LNVG, I_LNVB, I_WS, I_BS, I_WOUTC, I_LNMG, I_LNMB, I_WR, I_WG, I_WU, I_WDN, I_LNFG, I_LNFB };

__device__ __forceinline__ void phase_prologue(KArgs a, LAS unsigned char* lds, int gw, int NGW, int wave, int lane) {
    unsigned char* ws = a->ws;
    constexpr int I_AB = 32 * 48, I_OAB = 32 * 16, I_C = 32 * 32, I_OC = 32 * 16, I_ALL = 2 * (I_AB + I_OAB + I_C + I_OC);
    LAS unsigned char* scr = lds + 4096 + wave * 4096;
    const unsigned lo4 = 4u * (unsigned)lane, lane16 = 16u * (unsigned)lane; unsigned wofs, swz; im_lane(lane, wofs, swz);
    auto dense_item = [&](int it) -> ImItem {
        int r = it; const int i = r & 1; r >>= 1;
        if (r < I_AB) return im_dense_item(a->in[I_WINAB] + (size_t)i * D * QKVW, QKVW, D, (bf16_t*)(ws + WS_WINAB) + (size_t)i * QKVW * D, r / 48, r % 48);
        if ((r -= I_AB) < I_OAB) return im_dense_item(a->in[I_WOUTAB] + (size_t)i * D * D, D, D, (bf16_t*)(ws + WS_WOUTAB) + (size_t)i * D * D, r / 16, r % 16);
        if ((r -= I_OAB) < I_C) return im_dense_item(a->in[I_WINC] + (size_t)i * D * 2048, 2048, D, (bf16_t*)(ws + WS_WINC) + (size_t)i * 2048 * D, r / 32, r % 32);
        r -= I_C; return im_dense_item(a->in[I_WOUTC] + (size_t)i * D * D, D, D, (bf16_t*)(ws + WS_WOUTC) + (size_t)i * D * D, r / 16, r % 16); };
    for (int it = gw; it < I_ALL; it += 2 * NGW) {
        const bool two = it + NGW < I_ALL;
        const ImItem I0 = dense_item(it), I1 = dense_item(two ? it + NGW : it);
        float v0[32], v1[32]; IM_LOAD(v0, I0, lo4); IM_LOAD(v1, I1, lo4);
        asm volatile("" ::: "memory");
        IM_STORE(v0, I0, scr, wofs, swz, lane16);
        if (two) IM_STORE(v1, I1, scr, wofs, swz, lane16);
    }
    { const float* src = a->in[I_WS]; bf16_t* dst = (bf16_t*)(ws + WS_WSB);
      for (int i = gw * 64 + lane; i < 262144 / 8; i += NGW * 64) { const f32x4 v0 = *(const f32x4*)(src + (size_t)i * 8), v1 = *(const f32x4*)(src + (size_t)i * 8 + 4);
          u32x4 o; o.x = cvt_pk_bf16(v0[0], v0[1]); o.y = cvt_pk_bf16(v0[2], v0[3]); o.z = cvt_pk_bf16(v1[0], v1[1]); o.w = cvt_pk_bf16(v1[2], v1[3]); *(u32x4*)(dst + (size_t)i * 8) = o; } }
    { const float* x = a->in[I_X]; bf16_t* xb = (bf16_t*)(ws + WS_XB);
      for (int m = gw; m < T; m += 4 * NGW) { f32x4 v[4][4];
#pragma unroll
          for (int r = 0; r < 4; ++r) { const int mr = (m + r * NGW < T) ? m + r * NGW : m; const f32x4* xr = (const f32x4*)(x + (size_t)mr * D) + lane;
#pragma unroll
              for (int j = 0; j < 4; ++j) v[r][j] = xr[64 * j]; }
          asm volatile("" ::: "memory");
#pragma unroll
          for (int r = 0; r < 4; ++r) { if (m + r * NGW < T) { u32x2* o = (u32x2*)(xb + (size_t)(m + r * NGW) * D) + lane;
#pragma unroll
              for (int j = 0; j < 4; ++j) { u32x2 w; w.x = cvt_pk_bf16(v[r][j][0], v[r][j][1]); w.y = cvt_pk_bf16(v[r][j][2], v[r][j][3]); o[64 * j] = w; } } } } }
}

__device__ __forceinline__ ImItem moe_item(const float* wg, const float* wu, const float* wd, unsigned char* ws, unsigned it) {
    const unsigned e = it / 3072u; unsigned r = it % 3072u; const unsigned which = r >> 10; r &= 1023u; ImItem I;
    if (which < 2) { const unsigned kh = r >> 5, nb = r & 31u; I.src = (const char*)((which ? wu : wg) + (size_t)e * D * DEXP + (size_t)(32 * kh) * DEXP + 64 * nb); I.ldw4 = DEXP * 4;
        I.dst = (char*)ws + WS_WGU + ((size_t)(e * 32 + (nb >> 1) * 2 + which) * 16 + (kh >> 1)) * 16384 + (size_t)(((nb & 1) * 4) * 2 + (kh & 1)) * 1024; }
    else { const unsigned kh = r >> 4, nb = r & 15u; I.src = (const char*)(wd + (size_t)e * DEXP * D + (size_t)(32 * kh) * D + 64 * nb); I.ldw4 = D * 4;
        I.dst = (char*)ws + WS_WD + ((size_t)(e * 8 + (nb >> 1)) * 32 + (kh >> 1)) * 16384 + (size_t)(((nb & 1) * 4) * 2 + (kh & 1)) * 1024; }
    return I;
}
__device__ __forceinline__ void phase_moe_convert(KArgs a, int l, LAS unsigned char* lds, int gw, int NGW, int wave, int lane, int qsel = 0) {
    unsigned char* ws = a->ws + (size_t)(l & 1) * WS_WDELTA;
    const float* wg = a->in[I_WG] + (size_t)l * NE * D * DEXP; const float* wu = a->in[I_WU] + (size_t)l * NE * D * DEXP; const float* wd = a->in[I_WDN] + (size_t)l * NE * DEXP * D;
    constexpr unsigned TOT = NE * 3 * 1024;
    unsigned* qhead = (unsigned*)(a->ws + WS_CTL) + 1024 + 64 * l + 32 * qsel;
    LAS unsigned char* scr = lds + 4096 + wave * 4096;
    const unsigned lo4 = 4u * (unsigned)lane, lane16 = 16u * (unsigned)lane; unsigned wofs, swz; im_lane(lane, wofs, swz);
#define MC_TICKET() __builtin_amdgcn_atomic_inc32(qhead, 0xffffffffu, __ATOMIC_RELAXED, "agent")
    unsigned tkv = 0; if (lane == 0) tkv = MC_TICKET();
    unsigned cur = 16u * (unsigned)__builtin_amdgcn_readfirstlane((int)tkv), left = 16;
    if (cur >= TOT) return;
    tkv = 0; if (lane == 0) tkv = MC_TICKET();
#define MC_NEXT(id) do { if (left == 0) { unsigned z_; asm volatile("v_mov_b32 %0, 0" : "=v"(z_)); cur = 16u * (unsigned)__builtin_amdgcn_readfirstlane((int)(tkv + z_)); left = 16; tkv = TOT / 16; \
            if (cur < TOT && lane == 0) tkv = MC_TICKET(); } \
        id = cur; if (cur < TOT) { ++cur; --left; } } while (0)
    float va[32], vb[32];
    unsigned ida, idb; ImItem Ia, Ib;
    MC_NEXT(ida); Ia = moe_item(wg, wu, wd, ws, ida); IM_LOAD_NT(va, Ia, lo4);
    MC_NEXT(idb); Ib = moe_item(wg, wu, wd, ws, idb < TOT ? idb : TOT - 1); IM_LOAD_NT(vb, Ib, lo4);
    asm volatile("" ::: "memory");
    do {
        IM_STORE_NT(va, Ia, scr, wofs, swz, lane16);
        asm volatile("" ::: "memory");
        MC_NEXT(ida); Ia = moe_item(wg, wu, wd, ws, ida < TOT ? ida : TOT - 1); IM_LOAD_NT(va, Ia, lo4);
        asm volatile("" ::: "memory");
        IM_STORE_NT(vb, Ib, scr, wofs, swz, lane16);
        asm volatile("" ::: "memory");
        MC_NEXT(idb); Ib = moe_item(wg, wu, wd, ws, idb < TOT ? idb : TOT - 1); IM_LOAD_NT(vb, Ib, lo4);
        asm volatile("" ::: "memory");
    } while (ida < TOT);
#undef MC_NEXT
#undef MC_TICKET
}

constexpr int RT_PITCH = 2064;
constexpr int RT_WLO = 16 * RT_PITCH, RT_XT = 2 * 16 * RT_PITCH;
template <bool L0> __device__ __forceinline__ void phase_ln_router(KArgs a, int l, LAS unsigned char* lds, int gw, int NGW, int tid, int lane) {
    unsigned char* ws = a->ws;
    const float* xres = a->in[I_X];
    const bf16_t* hm = (const bf16_t*)(ws + WS_HM);
    bf16_t* xb = (bf16_t*)(ws + WS_XB);
    float* afft = (float*)(ws + WS_AFFT); int* inv = (int*)(ws + WS_INV);
    const float* lg = a->in[I_LNMG] + (size_t)l * D; const float* lb = a->in[I_LNMB] + (size_t)l * D; const float* wr = a->in[I_WR] + (size_t)l * D * NE;
    const int wid = tid >> 6;
    { float wv[32];
#pragma unroll
      for (int u = 0; u < 32; ++u) wv[u] = wr[tid + u * (NWAVES * 64)];
#pragma unroll
      for (int u = 0; u < 32; ++u) { const int i = tid + u * (NWAVES * 64); const int k = i >> 4, e = i & 15; const float w = wv[u];
        const unsigned hi = cvt_pk_bf16(w, 0.f) & 0xffffu; const float rem = w - __uint_as_float(hi << 16);
        *(LAS bf16_t*)(lds + e * RT_PITCH + k * 2) = (bf16_t)hi; *(LAS bf16_t*)(lds + RT_WLO + e * RT_PITCH + k * 2) = (bf16_t)(cvt_pk_bf16(rem, 0.f) & 0xffffu); } }
    __syncthreads();
    f32x4 gv[4], bv[4];
#pragma unroll
    for (int j = 0; j < 4; ++j) { gv[j] = *((const f32x4*)lg + lane + 64 * j); bv[j] = *((const f32x4*)lb + lane + 64 * j); }
    LAS unsigned char* xt = lds + RT_XT + wid * (4 * RT_PITCH);
    const unsigned lds0 = (unsigned)(uintptr_t)lds;
    const unsigned xa = lds0 + RT_XT + wid * (4 * RT_PITCH) + (lane & 3) * RT_PITCH + (lane >> 4) * 16;
    const unsigned wa = lds0 + (lane & 15) * RT_PITCH + (lane >> 4) * 16;
    u32x4 xs0[4], xs1[4], xs2[4], xs3[4]; u32x2 hs0[4], hs1[4], hs2[4], hs3[4];
#define LR_LOAD(X, H, M) do { const int m_ = (M) < T ? (M) : T - 1; \
        if (L0) { _Pragma("unroll") for (int j = 0; j < 4; ++j) X[j] = *((const u32x4*)(xres + (size_t)m_ * D) + lane + 64 * j); } \
        else { _Pragma("unroll") for (int j = 0; j < 4; ++j) { const u32x2 r_ = *((const u32x2*)(xb + (size_t)m_ * D) + lane + 64 * j); X[j].x = r_.x; X[j].y = r_.y; } } \
        _Pragma("unroll") for (int j = 0; j < 4; ++j) H[j] = *((const u32x2*)(hm + (size_t)m_ * D) + lane + 64 * j); } while (0)
#define LR_ROW(X, H, RJ, M) do { const int m = (M); \
            f32x4 v[4]; float s = 0.f; \
            _Pragma("unroll") for (int j = 0; j < 4; ++j) { const u32x4 xr_ = X[j]; const u32x2 h = H[j]; \
                const f32x4 x = L0 ? __builtin_bit_cast(f32x4, xr_) : (f32x4){bf_lo(xr_.x), bf_hi(xr_.x), bf_lo(xr_.y), bf_hi(xr_.y)}; \
                v[j] = (f32x4){ALPHA * x[0] + bf_lo(h.x), ALPHA * x[1] + bf_hi(h.x), ALPHA * x[2] + bf_lo(h.y), ALPHA * x[3] + bf_hi(h.y)}; \
                s += (v[j][0] + v[j][1]) + (v[j][2] + v[j][3]); } \
            const float mean = wave_sum_dpp(s) * (1.f / D); float s2 = 0.f; \
            _Pragma("unroll") for (int j = 0; j < 4; ++j) { v[j] = v[j] - mean; s2 += (v[j][0] * v[j][0] + v[j][1] * v[j][1]) + (v[j][2] * v[j][2] + v[j][3] * v[j][3]); } \
            const float rstd = 1.f / sqrtf(wave_sum_dpp(s2) * (1.f / D) + LN_EPS); \
            u32x2* ob = (u32x2*)(xb + (size_t)m * D) + lane; LAS u32x2* ot = (LAS u32x2*)(xt + (RJ) * RT_PITCH) + lane; \
            _Pragma("unroll") for (int j = 0; j < 4; ++j) { v[j] = v[j] * rstd * gv[j] + bv[j]; u32x2 w; w.x = cvt_pk_bf16(v[j][0], v[j][1]); w.y = cvt_pk_bf16(v[j][2], v[j][3]); if (m < T) ob[64 * j] = w; ot[64 * j] = w; } } while (0)
    LR_LOAD(xs0, hs0, gw); asm volatile("" ::: "memory"); LR_LOAD(xs1, hs1, gw + NGW); asm volatile("" ::: "memory"); LR_LOAD(xs2, hs2, gw + 2 * NGW); asm volatile("" ::: "memory");
    for (int m0 = gw; m0 < T; m0 += 4 * NGW) {
        LR_LOAD(xs3, hs3, m0 + 3 * NGW); asm volatile("" ::: "memory"); LR_ROW(xs0, hs0, 0, m0);
        LR_LOAD(xs0, hs0, m0 + 4 * NGW); asm volatile("" ::: "memory"); LR_ROW(xs1, hs1, 1, m0 + NGW);
        LR_LOAD(xs1, hs1, m0 + 5 * NGW); asm volatile("" ::: "memory"); LR_ROW(xs2, hs2, 2, m0 + 2 * NGW);
        LR_LOAD(xs2, hs2, m0 + 6 * NGW); asm volatile("" ::: "memory"); LR_ROW(xs3, hs3, 3, m0 + 3 * NGW);
        LDS_WAIT();
        f32x4 acc = {0.f, 0.f, 0.f, 0.f};
#pragma unroll 8
        for (int sk = 0; sk < 32; ++sk) { bf16x8 af, bh, bl; const unsigned xo = xa + sk * 64, wo = wa + sk * 64; LDS_RD128(af, xo, 0); LDS_RD128(bh, wo, 0); LDS_RD128(bl, wo, RT_WLO);
            asm volatile("s_waitcnt lgkmcnt(0)" : "+v"(af), "+v"(bh), "+v"(bl));
            acc = __builtin_amdgcn_mfma_f32_16x16x32_bf16(af, bh, acc, 0, 0, 0); acc = __builtin_amdgcn_mfma_f32_16x16x32_bf16(af, bl, acc, 0, 0, 0); }
#pragma unroll
        for (int i = 0; i < 4; ++i) { const int m = m0 + i * NGW; float x = acc[i];
            float mx = x; mx = fmaxf(mx, __builtin_bit_cast(float, __builtin_amdgcn_update_dpp(0, __builtin_bit_cast(int, mx), 0xB1, 0xf, 0xf, false)));
            mx = fmaxf(mx, __builtin_bit_cast(float, __builtin_amdgcn_update_dpp(0, __builtin_bit_cast(int, mx), 0x4E, 0xf, 0xf, false)));
            mx = fmaxf(mx, __builtin_bit_cast(float, __builtin_amdgcn_update_dpp(0, __builtin_bit_cast(int, mx), 0x141, 0xf, 0xf, false)));
            mx = fmaxf(mx, __builtin_bit_cast(float, __builtin_amdgcn_update_dpp(0, __builtin_bit_cast(int, mx), 0x140, 0xf, 0xf, false)));
            const float p = __expf(x - mx); float sm = p;
            sm = dpp_add<0xB1, 0xf>(sm); sm = dpp_add<0x4E, 0xf>(sm); sm = dpp_add<0x141, 0xf>(sm); sm = dpp_add<0x140, 0xf>(sm);
            if (lane < 16 && m < T) { const int b = m >> 13, t = m & (SEQ - 1); afft[((size_t)(b * NE + lane) << 13) + t] = p / sm; inv[(size_t)m * NE + lane] = -1; } }
    }
#undef LR_LOAD
#undef LR_ROW
}

__device__ __forceinline__ void topk_unit(KArgs a, int list, LAS unsigned char* lds, int tid, int wave, int lane) {
    unsigned char* ws = a->ws;
    const float* src = (const float*)(ws + WS_AFFT) + (size_t)list * SEQ;
    int* selt = (int*)(ws + WS_SELT); float* selg = (float*)(ws + WS_SELG); int* inv = (int*)(ws + WS_INV);
    const int b = list >> 4, e = list & 15;
    LAS unsigned* hist = (LAS unsigned*)lds;
    LAS unsigned* sc = hist + 2048;
    LAS unsigned* wtot = hist + 2048 + 64;
    unsigned key[16];
#pragma unroll
    for (int j = 0; j < 4; ++j) { const u32x4 v = *((const u32x4*)(src + tid * 16) + j); key[4 * j] = v.x; key[4 * j + 1] = v.y; key[4 * j + 2] = v.z; key[4 * j + 3] = v.w; }
    unsigned prefix = 0, need = CAP;
#pragma unroll
    for (int pass = 0; pass < 3; ++pass) {
        const int shift = (pass == 0) ? 21 : (pass == 1) ? 10 : 0; const int nb = (pass == 2) ? 1024 : 2048; const int per = nb / 64;
#pragma unroll
        for (int q = 0; q < 4; ++q) hist[tid + q * 512] = 0u;
        __syncthreads();
#pragma unroll
        for (int j = 0; j < 16; ++j) { const unsigned k = key[j]; const bool match = (pass == 0) || ((pass == 1 ? (k >> 21) : (k >> 10)) == prefix); if (match) __hip_atomic_fetch_add(&hist[(k >> shift) & (unsigned)(nb - 1)], 1u, __ATOMIC_RELAXED, __HIP_MEMORY_SCOPE_WORKGROUP); }
        __syncthreads();
        if (wave == 0) {
            unsigned s = 0; const int top = nb - 1 - per * lane;
            for (int q = 0; q < per; ++q) s += hist[top - q];
            unsigned incl = s;
#pragma unroll
            for (int o = 1; o < 64; o <<= 1) { const unsigned t = (unsigned)__builtin_amdgcn_ds_bpermute((lane - o) << 2, (int)incl); if (lane >= o) incl += t; }
            const unsigned long long bal = __ballot(incl >= need);
            const int first = __ffsll((long long)bal) - 1;
            if (lane == first) { unsigned before = incl - s; int q = 0;
                for (q = 0; q < per - 1; ++q) { const unsigned c = hist[top - q]; if (before + c >= need) break; before += c; }
                sc[0] = (prefix << (pass == 2 ? 10 : 11)) | (unsigned)(top - q); sc[1] = need - before; }
        }
        __syncthreads();
        prefix = sc[0]; need = sc[1];
        __syncthreads();
    }
    const unsigned thr = prefix;
    unsigned cg = 0, ce = 0;
#pragma unroll
    for (int j = 0; j < 16; ++j) { cg += key[j] > thr ? 1u : 0u; ce += key[j] == thr ? 1u : 0u; }
    unsigned ig = cg, ie = ce;
#pragma unroll
    for (int o = 1; o < 64; o <<= 1) { const unsigned t1 = (unsigned)__builtin_amdgcn_ds_bpermute((lane - o) << 2, (int)ig), t2 = (unsigned)__builtin_amdgcn_ds_bpermute((lane - o) << 2, (int)ie); if (lane >= o) { ig += t1; ie += t2; } }
    if (lane == 63) { wtot[wave] = ig; wtot[8 + wave] = ie; }
    __syncthreads();
    unsigned bg = 0, be = 0;
    for (int w = 0; w < wave; ++w) { bg += wtot[w]; be += wtot[8 + w]; }
    unsigned pg = bg + ig - cg, pe = be + ie - ce;
    const unsigned totalG = CAP - need;
#pragma unroll
    for (int j = 0; j < 16; ++j) { const unsigned k = key[j]; int slot = -1;
        if (k > thr) { slot = (int)pg; ++pg; } else if (k == thr) { if (pe < need) slot = (int)(totalG + pe); ++pe; }
        if (slot >= 0) { const int tok = b * SEQ + tid * 16 + j; const int r = b * CAP + slot;
            selt[e * EROWS + r] = tok; selg[e * EROWS + r] = __uint_as_float(k); inv[(size_t)tok * NE + e] = r; } }
    __syncthreads();
}

#define CL_ISSUE_Y(MYR, Y, W, REST) do { unsigned long long _bal = __ballot((MYR) >= 0) & 0xffffull; \
        _Pragma("unroll") for (int s_ = 0; s_ < 4; ++s_) { const u32x2* yr_ = (const u32x2*)y + lane; W[s_] = 0.f; \
            if (_bal) { const int e_ = __ffsll((long long)_bal) - 1; _bal &= _bal - 1; const int r_ = __builtin_amdgcn_readlane((MYR), e_); yr_ = (const u32x2*)(y + ((size_t)e_ * EROWS + r_) * D) + lane; W[s_] = 1.f; } \
            _Pragma("unroll") for (int j = 0; j < 4; ++j) Y[s_][j] = yr_[64 * j]; } \
        REST = _bal; } while (0)
__device__ __forceinline__ void phase_combine_ln(KArgs a, int l, int gw, int NGW, int lane) {
    unsigned char* ws = a->ws;
    const bf16_t* y = (const bf16_t*)(ws + WS_QKV); const int* inv = (const int*)(ws + WS_INV);
    float* xf = a->out; bf16_t* xb = (bf16_t*)(ws + WS_XB);
    const float* lg = a->in[I_LNFG] + (size_t)l * D; const float* lb = a->in[I_LNFB] + (size_t)l * D;
    f32x4 gv[4], bv[4];
#pragma unroll
    for (int j = 0; j < 4; ++j) { gv[j] = *((const f32x4*)lg + lane + 64 * j); bv[j] = *((const f32x4*)lb + lane + 64 * j); }
    const int el = lane & 15;
    u32x2 xC[4], xB[4], xA[4]; u32x2 yC[4][4], yB[4][4]; float wC[4], wB[4]; unsigned long long restC = 0, restB = 0; int myrC = -1, myrB = -1, myrA = -1;
    if (gw < T) { myrC = inv[(size_t)gw * NE + el];
#pragma unroll
        for (int j = 0; j < 4; ++j) xC[j] = *((const u32x2*)(xb + (size_t)gw * D) + lane + 64 * j);
        CL_ISSUE_Y(myrC, yC, wC, restC); }
    if (gw + NGW < T) { const int m1 = gw + NGW; myrB = inv[(size_t)m1 * NE + el];
#pragma unroll
        for (int j = 0; j < 4; ++j) xB[j] = *((const u32x2*)(xb + (size_t)m1 * D) + lane + 64 * j); }
    for (int m = gw; m < T; m += NGW) {
        const int mn = m + NGW, mnn = m + 2 * NGW;
        if (mn < T) CL_ISSUE_Y(myrB, yB, wB, restB);
        if (mnn < T) { myrA = inv[(size_t)mnn * NE + el];
#pragma unroll
            for (int j = 0; j < 4; ++j) xA[j] = *((const u32x2*)(xb + (size_t)mnn * D) + lane + 64 * j); }
        f32x4 v[4];
#pragma unroll
        for (int j = 0; j < 4; ++j) v[j] = (f32x4){bf_lo(xC[j].x), bf_hi(xC[j].x), bf_lo(xC[j].y), bf_hi(xC[j].y)} * ALPHA;
#pragma unroll
        for (int s_ = 0; s_ < 4; ++s_) { const float w = wC[s_];
#pragma unroll
            for (int j = 0; j < 4; ++j) { const u32x2 h = yC[s_][j]; v[j][0] += w * bf_lo(h.x); v[j][1] += w * bf_hi(h.x); v[j][2] += w * bf_lo(h.y); v[j][3] += w * bf_hi(h.y); } }
        while (restC) { const int e = __ffsll((long long)restC) - 1; restC &= restC - 1; const int r = __builtin_amdgcn_readlane(myrC, e);
            const u32x2* yr = (const u32x2*)(y + ((size_t)e * EROWS + r) * D) + lane;
#pragma unroll
            for (int j = 0; j < 4; ++j) { const u32x2 h = yr[64 * j]; v[j][0] += bf_lo(h.x); v[j][1] += bf_hi(h.x); v[j][2] += bf_lo(h.y); v[j][3] += bf_hi(h.y); } }
        float s = 0.f;
#pragma unroll
        for (int j = 0; j < 4; ++j) s += (v[j][0] + v[j][1]) + (v[j][2] + v[j][3]);
        const float mean = wave_sum_dpp(s) * (1.f / D); float s2 = 0.f;
#pragma unroll
        for (int j = 0; j < 4; ++j) { v[j] = v[j] - mean; s2 += (v[j][0] * v[j][0] + v[j][1] * v[j][1]) + (v[j][2] * v[j][2] + v[j][3] * v[j][3]); }
        const float rstd = 1.f / sqrtf(wave_sum_dpp(s2) * (1.f / D) + LN_EPS);
        f32x4* of = (f32x4*)(xf + (size_t)m * D) + lane; u32x2* ob = (u32x2*)(xb + (size_t)m * D) + lane;
#pragma unroll
        for (int j = 0; j < 4; ++j) { v[j] = v[j] * rstd * gv[j] + bv[j]; if (l == DEPTH - 1) of[64 * j] = v[j]; else { u32x2 w; w.x = cvt_pk_bf16(v[j][0], v[j][1]); w.y = cvt_pk_bf16(v[j][2], v[j][3]); ob[64 * j] = w; } }
#pragma unroll
        for (int j = 0; j < 4; ++j) { xC[j] = xB[j]; xB[j] = xA[j]; }
#pragma unroll
        for (int s_ = 0; s_ < 4; ++s_) { wC[s_] = wB[s_];
#pragma unroll
            for (int j = 0; j < 4; ++j) yC[s_][j] = yB[s_][j]; }
        restC = restB; myrC = myrB; myrB = myrA;
    }
}
#undef CL_ISSUE_Y

__device__ __forceinline__ void qkt(f32x16& p0, f32x16& p1, lds_cptr Kslot, const bf16x8* qr, int r32, int hi) {
    lds_cptr kb = Kslot + hi * 1024 + r32 * 16;
    p0 = f32x16{}; p1 = f32x16{};
#pragma unroll
    for (int d0 = 0; d0 < 4; ++d0) {
        const bf16x8 b0 = *(const LAS bf16x8*)(kb + d0 * 2048);
        const bf16x8 b1 = *(const LAS bf16x8*)(kb + d0 * 2048 + 512);
        p0 = __builtin_amdgcn_mfma_f32_32x32x16_bf16(b0, qr[d0], p0, 0, 0, 0);
        p1 = __builtin_amdgcn_mfma_f32_32x32x16_bf16(b1, qr[d0], p1, 0, 0, 0); }
}
__device__ __forceinline__ void pack_p(const f32x16& p0, const f32x16& p1, bf16x8& a0, bf16x8& a1, bf16x8& a2, bf16x8& a3) {
    u32x4 w0 = {cvt_pk_bf16(p0[0], p0[1]), cvt_pk_bf16(p0[2], p0[3]), cvt_pk_bf16(p0[4], p0[5]), cvt_pk_bf16(p0[6], p0[7])};
    u32x4 w1 = {cvt_pk_bf16(p0[8], p0[9]), cvt_pk_bf16(p0[10], p0[11]), cvt_pk_bf16(p0[12], p0[13]), cvt_pk_bf16(p0[14], p0[15])};
    u32x4 w2 = {cvt_pk_bf16(p1[0], p1[1]), cvt_pk_bf16(p1[2], p1[3]), cvt_pk_bf16(p1[4], p1[5]), cvt_pk_bf16(p1[6], p1[7])};
    u32x4 w3 = {cvt_pk_bf16(p1[8], p1[9]), cvt_pk_bf16(p1[10], p1[11]), cvt_pk_bf16(p1[12], p1[13]), cvt_pk_bf16(p1[14], p1[15])};
    a0 = __builtin_bit_cast(bf16x8, w0); a1 = __builtin_bit_cast(bf16x8, w1); a2 = __builtin_bit_cast(bf16x8, w2); a3 = __builtin_bit_cast(bf16x8, w3);
}
template <int NQ> __device__ __forceinline__ void pv_acc(f32x16* o, lds_cptr vp, bf16x8 a0, bf16x8 a1, bf16x8 a2, bf16x8 a3) {
#pragma unroll
    for (int d0 = 0; d0 < NQ; ++d0) { s16x4 lo[4], hi4[4];
#pragma unroll
        for (int ks = 0; ks < 4; ++ks) { lo[ks] = vtr(vp + d0 * 4096 + ks * 1024); hi4[ks] = vtr(vp + d0 * 4096 + ks * 1024 + 512); }
#define PKV(k) (bf16x8){lo[k][0], lo[k][1], lo[k][2], lo[k][3], hi4[k][0], hi4[k][1], hi4[k][2], hi4[k][3]}
        o[d0] = __builtin_amdgcn_mfma_f32_32x32x16_bf16(a0, PKV(0), o[d0], 0, 0, 0);
        o[d0] = __builtin_amdgcn_mfma_f32_32x32x16_bf16(a1, PKV(1), o[d0], 0, 0, 0);
        o[d0] = __builtin_amdgcn_mfma_f32_32x32x16_bf16(a2, PKV(2), o[d0], 0, 0, 0);
        o[d0] = __builtin_amdgcn_mfma_f32_32x32x16_bf16(a3, PKV(3), o[d0], 0, 0, 0);
        SBAR();
#undef PKV
    }
}
template <int NQ> __device__ __forceinline__ void softmax_step(f32x16& p0, f32x16& p1, float& m, float& l, f32x16* o, LAS float* wsf, int r32, int hi) {
    float rm = fmaxf(p0[0], p1[0]);
#pragma unroll
    for (int r = 1; r < 16; ++r) rm = fmaxf(rm, fmaxf(p0[r], p1[r]));
    rm = pl32_max(rm);
    if (__any(rm > m + 8.0f)) {
        const float mn = fmaxf(m, rm); const float al = __builtin_amdgcn_exp2f(m - mn); m = mn; l *= al;
        if (hi == 0) wsf[r32] = al;
        LDS_WAIT();
#pragma unroll
        for (int r = 0; r < 16; ++r) { const float f = wsf[crow(r, hi)];
#pragma unroll
            for (int d0 = 0; d0 < NQ; ++d0) o[d0][r] *= f; }
    }
    float s = 0.f;
#pragma unroll
    for (int r = 0; r < 16; ++r) { p0[r] = __builtin_amdgcn_exp2f(p0[r] - m); p1[r] = __builtin_amdgcn_exp2f(p1[r] - m); s += p0[r] + p1[r]; }
    l += s;
}

__device__ __forceinline__ void phase_key_norms(const bf16_t* qkv, float* kn, int gw, int NGW, int lane) {
    for (int item = gw; item < BATCH * 4 * 128; item += NGW) {
        const int b = item >> 9, h = (item >> 7) & 3, t = item & 127;
        const bf16_t* p = qkv + ((size_t)b * SEQ + t * 64 + (lane >> 4)) * QKVW + 2048 + h * 128 + (lane & 15) * 8;
        u32x4 x[16];
#pragma unroll
        for (int j = 0; j < 16; ++j) x[j] = *(const u32x4*)(p + (size_t)(4 * j) * QKVW);
        float mx = 0.f;
#pragma unroll
        for (int j = 0; j < 16; ++j) { const u32x4 v = x[j];
            float sq = bf_lo(v.x) * bf_lo(v.x) + bf_hi(v.x) * bf_hi(v.x) + bf_lo(v.y) * bf_lo(v.y) + bf_hi(v.y) * bf_hi(v.y) + bf_lo(v.z) * bf_lo(v.z) + bf_hi(v.z) * bf_hi(v.z) + bf_lo(v.w) * bf_lo(v.w) + bf_hi(v.w) * bf_hi(v.w);
            sq = dpp_add<0xB1, 0xf>(sq); sq = dpp_add<0x4E, 0xf>(sq); sq = dpp_add<0x141, 0xf>(sq);
            mx = fmaxf(mx, sq); }
        const float n = wave_max(mx);
        if (lane == 0) kn[item] = sqrtf(n) * 1.001f;
    }
}

#define MX3(a, b, c) __builtin_fmaxf(__builtin_fmaxf((a), (b)), (c))
constexpr int DA_LIST_OFF = 81920;
__device__ __forceinline__ void diff_attn_unit(const bf16_t* qkv, bf16_t* mix, const float* kn, int b, int h, int qb, float lam, float sl2, const float* subg, float outscale,
                                               LAS unsigned char* lds, int tid, int wid, int lane) {
    const int r32 = lane & 31, hi = lane >> 5, mp = wid >> 2, rg = wid & 3;
    const size_t rowbase = (size_t)b * SEQ; const int q0 = qb * 128;
    LAS float* wsf = (LAS float*)(lds + SCR_OFF + wid * 512);
    LAS int* lst = (LAS int*)(lds + DA_LIST_OFF);
    const unsigned lds0 = (unsigned)(uintptr_t)lds;
    const char* kvb = (const char*)(qkv + rowbase * QKVW);
    const int td0 = q0 >> 6;
    const int kcol = 2048 + h * 128 + (wid >> 2) * 64 + (4 * ((wid & 3) >> 1) + ((lane & 3) ^ ((lane >> 4) & 3))) * 8;
    const unsigned koff = (unsigned)((32 * (wid & 1) + (lane >> 2)) * QKVW + kcol) * 2u;
    const unsigned voff = (unsigned)((16 * ((2 * wid) & 3) + (lane >> 2)) * QKVW + 2560 + h * 128 + ((2 * wid) >> 2) * 32 + (lane & 3) * 8) * 2u;
    const unsigned koffR = (unsigned)((63 - (32 * (wid & 1) + (lane >> 2))) * QKVW + kcol) * 2u;
    const unsigned voffR = (unsigned)((63 - (16 * ((2 * wid) & 3) + (lane >> 2))) * QKVW + 2560 + h * 128 + ((2 * wid) >> 2) * 32 + (lane & 3) * 8) * 2u;
#define DA_GL(src, voff_, dst) glds16s((src), (voff_), (unsigned)__builtin_amdgcn_readfirstlane((int)(dst)))
#define DA_DMA(t, kbuf, vbuf) do { const char* _tb = kvb + (size_t)(t) * (64 * QKVW * 2); const unsigned _kd = lds0 + (kbuf) * 16384 + wid * 2048, _vd = lds0 + 32768 + (vbuf) * 16384 + wid * 2048; \
        if ((t) > td0 + 1) { DA_GL(_tb, koffR, _kd); DA_GL(_tb - 16 * QKVW * 2, koffR, _kd + 1024); DA_GL(_tb, voffR, _vd); DA_GL(_tb - 16 * QKVW * 2, voffR, _vd + 1024); } \
        else { DA_GL(_tb, koff, _kd); DA_GL(_tb + 16 * QKVW * 2, koff, _kd + 1024); DA_GL(_tb, voff, _vd); DA_GL(_tb + 16 * QKVW * 2, voff, _vd + 1024); } } while (0)
#define DA_DMA_K(t, kbuf) do { const char* _tb = kvb + (size_t)(t) * (64 * QKVW * 2); const unsigned _kd = lds0 + (kbuf) * 16384 + wid * 2048; \
        if ((t) > td0 + 1) { DA_GL(_tb, koffR, _kd); DA_GL(_tb - 16 * QKVW * 2, koffR, _kd + 1024); } else { DA_GL(_tb, koff, _kd); DA_GL(_tb + 16 * QKVW * 2, koff, _kd + 1024); } } while (0)
#define DA_DMA_V(t, vbuf) do { const char* _tb = kvb + (size_t)(t) * (64 * QKVW * 2); const unsigned _vd = lds0 + 32768 + (vbuf) * 16384 + wid * 2048; \
        if ((t) > td0 + 1) { DA_GL(_tb, voffR, _vd); DA_GL(_tb - 16 * QKVW * 2, voffR, _vd + 1024); } else { DA_GL(_tb, voff, _vd); DA_GL(_tb + 16 * QKVW * 2, voff, _vd + 1024); } } while (0)
    DA_DMA(td0, 0, 0);
    float kn0 = 0.f, kn1 = 0.f; if (wid == 0) { const float* knp = kn + (b * 4 + h) * 128; kn0 = knp[lane]; kn1 = knp[lane + 64]; }
    const int tspec = (td0 > 0) ? td0 - 1 : td0 + 2;
    const bf16_t* Qw = qkv + (rowbase + q0 + rg * 32 + r32) * QKVW + 1536 + h * 128 + mp * 64 + hi * 8;
    bf16x8 qr[4];
#pragma unroll
    for (int d0 = 0; d0 < 4; ++d0) qr[d0] = *(const bf16x8*)(Qw + d0 * 16);
    {
      float qs = 0.f;
#pragma unroll
      for (int d0 = 0; d0 < 4; ++d0) { const u32x4 w = __builtin_bit_cast(u32x4, qr[d0]);
          qs += bf_lo(w.x) * bf_lo(w.x) + bf_hi(w.x) * bf_hi(w.x) + bf_lo(w.y) * bf_lo(w.y) + bf_hi(w.y) * bf_hi(w.y) + bf_lo(w.z) * bf_lo(w.z) + bf_hi(w.z) * bf_hi(w.z) + bf_lo(w.w) * bf_lo(w.w) + bf_hi(w.w) * bf_hi(w.w); }
      qs = wave_max(pl32_sum(qs));
      if (lane == 0) wsf[64] = sqrtf(qs) * 1.001f; }
    f32x16 o[4];
#pragma unroll
    for (int d0 = 0; d0 < 4; ++d0) o[d0] = f32x16{};
    float m = -1e30f, l = 0.f;
    const int iq = q0 + rg * 32 + r32;
    const int vlane = ((lane >> 4) & 1) * 32 + (lane & 3) * 8 + (4 * hi + ((lane & 15) >> 2)) * 64;
    bf16x8 a0, a1, a2, a3;
    int vb = 0, vbp = 0;
#define DA_STEP(GENERAL, CPAT, T_, HASN_, TN_) do { \
        const int kb = it & 1; const int t = (T_); \
        VM_WAIT(); __syncthreads();                                 \
        const int vbn = (vb == 2) ? 0 : vb + 1; \
        const unsigned Kb_ = lds0 + kb * 16384 + mp * 8192 + (r32 >> 4) * 1024 + (r32 & 15) * 64; const unsigned Ka0 = Kb_ + ((hi ^ ((r32 >> 2) & 3)) << 4), Ka1 = Kb_ + (((2 + hi) ^ ((r32 >> 2) & 3)) << 4); \
        const unsigned va = lds0 + 32768 + ((mp == 1) ? vbp : vb) * 16384 + vlane;         \
        bf16x8 k0, k1, k2, k3, k4, k5, k6, k7; s16x4 xl0, xl1, xl2, xl3, xh0, xh1, xh2, xh3, yl0, yl1, yl2, yl3, yh0, yh1, yh2, yh3; \
        if (mp == 1 && it > 0) { PV_RD(xl, xh, 0); PV_RD(yl, yh, 1); PV_WAIT(8, xl, xh); __builtin_amdgcn_s_setprio(1); PV_MM(xl, xh, 0); PV_RD(xl, xh, 2); PV_WAIT(8, yl, yh); PV_MM(yl, yh, 1); PV_RD(yl, yh, 3); PV_WAIT(8, xl, xh); PV_MM(xl, xh, 2); PV_WAIT(0, yl, yh); PV_MM(yl, yh, 3); __builtin_amdgcn_s_setprio(0); } \
          \
        LDS_RD128(k0, Ka0, 0); LDS_RD128(k1, Ka0, 2048); LDS_RD128(k2, Ka1, 0); LDS_RD128(k3, Ka1, 2048); \
        if (HASN_) { const int tn = (TN_); DA_DMA_K(tn, kb ^ 1); } \
        f32x16 p0, p1; float A0, A1; \
        asm volatile("s_waitcnt lgkmcnt(2)" : "+v"(k0), "+v"(k1)); __builtin_amdgcn_s_setprio(1); \
        p0 = __builtin_amdgcn_mfma_f32_32x32x16_bf16(k0, qr[0], CPAT, 0, 0, 0); p1 = __builtin_amdgcn_mfma_f32_32x32x16_bf16(k1, qr[0], CPAT, 0, 0, 0); \
        asm volatile("" : "+v"(p0), "+v"(p1)); LDS_RD128(k4, Ka0, 4096); LDS_RD128(k5, Ka0, 6144); \
        asm volatile("s_waitcnt lgkmcnt(2)" : "+v"(k2), "+v"(k3)); \
        p0 = __builtin_amdgcn_mfma_f32_32x32x16_bf16(k2, qr[1], p0, 0, 0, 0); p1 = __builtin_amdgcn_mfma_f32_32x32x16_bf16(k3, qr[1], p1, 0, 0, 0); \
        asm volatile("" : "+v"(p0), "+v"(p1)); LDS_RD128(k6, Ka1, 4096); LDS_RD128(k7, Ka1, 6144); \
        asm volatile("s_waitcnt lgkmcnt(2)" : "+v"(k4), "+v"(k5)); \
        p0 = __builtin_amdgcn_mfma_f32_32x32x16_bf16(k4, qr[2], p0, 0, 0, 0); p1 = __builtin_amdgcn_mfma_f32_32x32x16_bf16(k5, qr[2], p1, 0, 0, 0); \
        asm volatile("s_waitcnt lgkmcnt(0)" : "+v"(k6), "+v"(k7)); \
        p0 = __builtin_amdgcn_mfma_f32_32x32x16_bf16(k6, qr[3], p0, 0, 0, 0); p1 = __builtin_amdgcn_mfma_f32_32x32x16_bf16(k7, qr[3], p1, 0, 0, 0); \
        asm volatile("" : "+v"(p0), "+v"(p1)); __builtin_amdgcn_s_setprio(0); \
        if (mp == 0) PV_RD(xl, xh, 0);                              \
        if (GENERAL) { A0 = 0.f; A1 = 0.f; const float di0 = (float)(iq - t * 64 - 4 * hi); \
            _Pragma("unroll") for (int r = 0; r < 16; ++r) { const float c = (float)((r & 3) + 8 * (r >> 2)); p0[r] -= sl2 * fabsf(di0 - c); p1[r] -= sl2 * fabsf(di0 - 32.f - c); } } \
        else { const int dd = (t < td0) ? (iq - t * 64) : (t * 64 + 63 - iq); A0 = -sl2 * (float)(dd - 4 * hi); A1 = A0 + 32.f * sl2; } \
          \
        float x0 = MX3(p0[0], p0[1], p0[2]), x1 = MX3(p1[0], p1[1], p1[2]); \
        _Pragma("unroll") for (int r = 3; r < 15; r += 2) { x0 = MX3(x0, p0[r], p0[r + 1]); x1 = MX3(x1, p1[r], p1[r + 1]); } \
        x0 = fmaxf(x0, p0[15]); x1 = fmaxf(x1, p1[15]); \
        const float rm = pl32_max(fmaxf(x0 + A0, x1 + A1)); \
        if (__any(rm > m + 8.0f)) { \
            const float mn = fmaxf(m, rm); const float al = __builtin_amdgcn_exp2f(m - mn); m = mn; l *= al; \
            if (hi == 0) wsf[r32] = al; \
            LDS_WAIT(); \
            _Pragma("unroll") for (int r = 0; r < 16; ++r) { const float f = wsf[crow(r, hi)]; \
                _Pragma("unroll") for (int d0 = 0; d0 < 4; ++d0) o[d0][r] *= f; } \
        } \
        { const float mm0 = m - A0, mm1 = m - A1; float s0 = 0.f, s1 = 0.f; \
          _Pragma("unroll") for (int r = 0; r < 16; ++r) { p0[r] = __builtin_amdgcn_exp2f(p0[r] - mm0); p1[r] = __builtin_amdgcn_exp2f(p1[r] - mm1); s0 += p0[r]; s1 += p1[r]; } \
          l += s0 + s1; } \
        pack_p(p0, p1, a0, a1, a2, a3); \
        asm volatile("" : "+v"(a0), "+v"(a1), "+v"(a2), "+v"(a3)); \
        if (HASN_) { const int tn = (TN_); DA_DMA_V(tn, vbn); }        \
        if (mp == 0) { PV_RD(yl, yh, 1); PV_WAIT(8, xl, xh); __builtin_amdgcn_s_setprio(1); PV_MM(xl, xh, 0); PV_RD(xl, xh, 2); PV_WAIT(8, yl, yh); PV_MM(yl, yh, 1); PV_RD(yl, yh, 3); PV_WAIT(8, xl, xh); PV_MM(xl, xh, 2); PV_WAIT(0, yl, yh); PV_MM(yl, yh, 3); __builtin_amdgcn_s_setprio(0); } \
        vbp = vb; vb = vbn; } while (0)
    { const f32x16 zc = f32x16{};
      _Pragma("nounroll") for (int it = 0; it < 2; ++it) DA_STEP(true, zc, td0 + it, true, (it == 0 ? td0 + 1 : tspec)); }
    { const float mw = -wave_max(-m);
      const float lw = -wave_max(-pl32_sum(l));
      if (lane == 0) { wsf[65] = mw; wsf[66] = lw; } }
    LDS_WAIT(); __syncthreads();
    if (wid == 0) {
        float qnw[8], mnw[8], lmin = 1e30f;
#pragma unroll
        for (int w = 0; w < 8; ++w) { const LAS float* ws2 = (const LAS float*)(lds + SCR_OFF + w * 512); qnw[w] = ws2[64]; mnw[w] = ws2[65]; lmin = fminf(lmin, ws2[66]); }
        const float kfac = uni_f(__builtin_amdgcn_logf((1.0f - __builtin_amdgcn_exp2f(-64.0f * sl2)) / (1.0f - __builtin_amdgcn_exp2f(-sl2))) + 0.002f);
        bool keep[2]; float ew[2];
#pragma unroll
        for (int j = 0; j < 2; ++j) { const int t = lane + 64 * j; const float knt = j ? kn1 : kn0; float e = -1e30f;
#pragma unroll
            for (int w = 0; w < 8; ++w) { const int rgw = w & 3; const int dw = (t < td0) ? 64 * (td0 - t) - 63 + 32 * rgw : 64 * (t - td0 - 2) + 97 - 32 * rgw;
                e = fmaxf(e, qnw[w] * knt - sl2 * (float)dw - mnw[w]); }
            ew[j] = (t != td0 && t != td0 + 1) ? e + 0.0625f + kfac : 1e30f; }
        float tau = -18.0f;
        _Pragma("nounroll") for (int k = 0; k < 44; ++k) {
            const float sl = (ew[0] < tau ? __builtin_amdgcn_exp2f(ew[0]) : 0.f) + (ew[1] < tau ? __builtin_amdgcn_exp2f(ew[1]) : 0.f);
            const float S = uni_f(wave_sum(sl));
            if (S <= 5.9604645e-8f * lmin) break;
            tau -= 0.5f; }
#pragma unroll
        for (int j = 0; j < 2; ++j) keep[j] = (ew[j] < 1e29f) && !(ew[j] < tau);
        unsigned long long b0 = __ballot(keep[0]), b1 = __ballot(keep[1]);
        const int ksel = (int)(((tspec < 64 ? b0 >> tspec : b1 >> (tspec - 64)) & 1ull));
        if (tspec < 64) b0 &= ~(1ull << tspec); else b1 &= ~(1ull << (tspec - 64));
        const unsigned long long below = (1ull << lane) - 1ull;
        const int n0 = __popcll(b0);
        if ((b0 >> lane) & 1ull) lst[ksel + __popcll(b0 & below)] = lane;
        if ((b1 >> lane) & 1ull) lst[ksel + n0 + __popcll(b1 & below)] = lane + 64;
        if (lane == 0) { lst[128] = ksel + n0 + __popcll(b1); lst[129] = ksel; if (ksel) lst[0] = tspec; }
    }
    LDS_WAIT(); __syncthreads();
    const int NTL = __builtin_amdgcn_readfirstlane(lst[128]);
    f32x16 patL;
#pragma unroll
    for (int r = 0; r < 16; ++r) patL[r] = sl2 * (float)((r & 3) + 8 * (r >> 2));
    asm volatile("" : "+v"(patL));
    if (NTL > 0 && __builtin_amdgcn_readfirstlane(lst[129]) == 0) { const int t0 = __builtin_amdgcn_readfirstlane(lst[0]); DA_DMA(t0, 0, vb); }
    _Pragma("nounroll") for (int it = 2; it < 2 + NTL; ++it) { const int tcur = __builtin_amdgcn_readfirstlane(lst[it - 2]); const bool hasn = (it - 1 < NTL);
        const int tnx = hasn ? __builtin_amdgcn_readfirstlane(lst[it - 1]) : 0;
        DA_STEP(false, patL, tcur, hasn, tnx); }
#undef DA_STEP
    if (mp == 1) { const unsigned va = lds0 + 32768 + vbp * 16384 + vlane; s16x4 xl0, xl1, xl2, xl3, xh0, xh1, xh2, xh3, yl0, yl1, yl2, yl3, yh0, yh1, yh2, yh3;
        PV_RD(xl, xh, 0); PV_RD(yl, yh, 1); PV_WAIT(8, xl, xh); PV_MM(xl, xh, 0); PV_RD(xl, xh, 2); PV_WAIT(8, yl, yh); PV_MM(yl, yh, 1); PV_RD(yl, yh, 3); PV_WAIT(8, xl, xh); PV_MM(xl, xh, 2); PV_WAIT(0, yl, yh); PV_MM(yl, yh, 3); }
    l = pl32_sum(l);
    if (hi == 0) wsf[r32] = (mp ? lam : 1.0f) / l;
    LDS_WAIT(); VM_WAIT();
    __syncthreads();
    LAS float* xch = (LAS float*)(lds + rg * 16384);
    if (mp == 1) {
#pragma unroll
        for (int r = 0; r < 16; ++r) { const float f = wsf[crow(r, hi)];
#pragma unroll
            for (int d0 = 0; d0 < 4; ++d0) xch[crow(r, hi) * 128 + d0 * 32 + r32] = o[d0][r] * f; }
    }
    __syncthreads();
    if (mp == 0) {
        float ss[16];
#pragma unroll
        for (int r = 0; r < 16; ++r) { const float f1 = wsf[crow(r, hi)]; float sq = 0.f;
#pragma unroll
            for (int d0 = 0; d0 < 4; ++d0) { const float v = o[d0][r] * f1 - xch[crow(r, hi) * 128 + d0 * 32 + r32]; o[d0][r] = v; sq += v * v; }
            ss[r] = sq; }
#pragma unroll
        for (int r = 0; r < 16; ++r) { ss[r] = half_sum(ss[r]); ss[r] = outscale / sqrtf(ss[r] * (1.f / 128.f) + RMS_EPS); }
        float gcol[4];
#pragma unroll
        for (int d0 = 0; d0 < 4; ++d0) gcol[d0] = subg[h * 128 + d0 * 32 + r32];
        char* Ow = (char*)(mix + (rowbase + q0 + rg * 32) * D + 512 + h * 128);
        int hi2 = hi; asm volatile("" : "+v"(hi2));
        const unsigned ob = (unsigned)((4 * hi2) * D + r32) * 2u;
#pragma unroll
        for (int r = 0; r < 16; ++r) { const unsigned orow = (unsigned)((r & 3) + 8 * (r >> 2));
#pragma unroll
            for (int d0 = 0; d0 < 4; ++d0) { const float v = o[d0][r] * ss[r] * gcol[d0]; *(bf16_t*)(Ow + (ob + (orow * D + d0 * 32) * 2u)) = (bf16_t)(cvt_pk_bf16(v, 0.f) & 0xffffu); } }
    }
    __syncthreads();
#undef DA_DMA
#undef DA_DMA_K
#undef DA_DMA_V
#undef DA_GL
}
#undef MX3

__device__ __forceinline__ void natten_unit(const bf16_t* qkv, bf16_t* mix, int b, int r, LAS unsigned char* lds, int wid, int lane) {
    const int r32 = lane & 31, hi = lane >> 5, h = wid;
    const size_t rowbase = (size_t)b * SEQ;
    const int rs = min(max(r - 4, 0), 120);
    const unsigned lds0 = (unsigned)(uintptr_t)lds + wid * 16384;
    LAS float* wsf = (LAS float*)(lds + SCR_OFF + wid * 512);
    bf16x8 qr[2][4];
    const bf16_t* Qw = qkv + (rowbase + (size_t)r * 64 + r32) * QKVW + h * 64 + hi * 8;
#pragma unroll
    for (int hq = 0; hq < 2; ++hq)
#pragma unroll
        for (int d0 = 0; d0 < 4; ++d0) qr[hq][d0] = *(const bf16x8*)(Qw + (size_t)hq * 32 * QKVW + d0 * 16);
    f32x16 o[2][2];
#pragma unroll
    for (int hq = 0; hq < 2; ++hq) { o[hq][0] = f32x16{}; o[hq][1] = f32x16{}; }
    float m[2] = {-1e30f, -1e30f}, l[2] = {0.f, 0.f};
    const int vlane = ((lane >> 4) & 1) * 32 + (lane & 3) * 8 + (4 * hi + ((lane & 15) >> 2)) * 64;
    const unsigned nkoff0 = (unsigned)((lane >> 3) * QKVW + 512 + h * 64) * 2u + (unsigned)(((lane & 7) ^ (lane >> 4)) << 4), nkoff1 = (unsigned)((lane >> 3) * QKVW + 512 + h * 64) * 2u + (unsigned)(((lane & 7) ^ ((lane >> 4) + 4)) << 4);
    const unsigned nvoff = (unsigned)((lane >> 2) * QKVW + 1024 + h * 64 + (lane & 3) * 8) * 2u;
    unsigned kna[4];
#pragma unroll
    for (int j = 0; j < 4; ++j) kna[j] = lds0 + (unsigned)(r32 * 128 + (((2 * j + hi) ^ ((r32 >> 1) & 7)) << 4));
#define NA_DMA_K(I) do { const char* tb_ = uni_ptr(qkv + (rowbase + (size_t)(rs + (I)) * 64) * QKVW); \
        _Pragma("nounroll") for (int c = 0; c < 8; c += 2) { glds16s(tb_ + (size_t)c * 8 * QKVW * 2, nkoff0, (unsigned)__builtin_amdgcn_readfirstlane((int)(lds0 + c * 1024))); \
            glds16s(tb_ + (size_t)(c + 1) * 8 * QKVW * 2, nkoff1, (unsigned)__builtin_amdgcn_readfirstlane((int)(lds0 + (c + 1) * 1024))); } } while (0)
#define NA_DMA_V(I) do { const char* tb_ = uni_ptr(qkv + (rowbase + (size_t)(rs + (I)) * 64) * QKVW); \
        _Pragma("nounroll") for (int p = 0; p < 8; ++p) glds16s(tb_ + (16 * (p & 3)) * QKVW * 2 + (p >> 2) * 64, nvoff, (unsigned)__builtin_amdgcn_readfirstlane((int)(lds0 + 8192 + p * 1024))); } while (0)
    NA_DMA_K(0); NA_DMA_V(0);
    for (int i = 0; i < 8; ++i) {
        asm volatile("s_waitcnt vmcnt(8)" ::: "memory");
        const int dr = rs + i - r + 7;
        f32x16 pq[2][2];
#pragma unroll
        for (int hq = 0; hq < 2; ++hq) { const f32x16 zc = f32x16{}; qkt_na(pq[hq][0], pq[hq][1], kna, qr[hq], zc); }
        asm volatile("s_waitcnt lgkmcnt(0)" ::: "memory");
        if (i < 7) NA_DMA_K(i + 1);
#pragma unroll
        for (int hq = 0; hq < 2; ++hq) {
            f32x16 p0 = pq[hq][0], p1 = pq[hq][1]; bf16x8 a0, a1, a2, a3;
            const int c = 32 * hq + r32; const int cs = min(max(c - 8, 0), 48);
            const unsigned bb = (unsigned)(uintptr_t)(lds + RPB_OFF) + (unsigned)(NA_PADB + h * 465 + dr * 31 + 4 * hi - c + 15) * 4u;
            const unsigned pb = (unsigned)(uintptr_t)(lds + RPB_OFF) + (unsigned)(NA_PEN + 48 + 4 * hi - cs) * 4u;
#define NA_LIVE0(rr) (hq == 0 || (rr) >= 12)
#define NA_LIVE1(rr) (hq == 1 || (rr) < 4)
            float rm = -1e30f;
            { float bA[16], pA[16];
#pragma unroll
              for (int rr = 0; rr < 16; ++rr) { const int jc = (rr & 3) + 8 * (rr >> 2);
                  if (NA_LIVE0(rr)) { asm volatile("ds_read_b32 %0, %1 offset:%c2" : "=v"(bA[rr]) : "v"(bb), "i"(jc * 4) : "memory"); asm volatile("ds_read_b32 %0, %1 offset:%c2" : "=v"(pA[rr]) : "v"(pb), "i"(jc * 4) : "memory"); } }
              asm volatile("s_waitcnt lgkmcnt(0)" ::: "memory");
#pragma unroll
              for (int rr = 0; rr < 16; ++rr) if (NA_LIVE0(rr)) { asm volatile("" : "+v"(bA[rr]), "+v"(pA[rr])); p0[rr] = p0[rr] + bA[rr] + pA[rr]; rm = fmaxf(rm, p0[rr]); }
#pragma unroll
              for (int rr = 0; rr < 16; ++rr) { const int jc = (rr & 3) + 8 * (rr >> 2);
                  if (NA_LIVE1(rr)) { asm volatile("ds_read_b32 %0, %1 offset:%c2" : "=v"(bA[rr]) : "v"(bb), "i"((jc + 32) * 4) : "memory"); asm volatile("ds_read_b32 %0, %1 offset:%c2" : "=v"(pA[rr]) : "v"(pb), "i"((jc + 32) * 4) : "memory"); } }
              asm volatile("s_waitcnt lgkmcnt(0)" ::: "memory");
#pragma unroll
              for (int rr = 0; rr < 16; ++rr) if (NA_LIVE1(rr)) { asm volatile("" : "+v"(bA[rr]), "+v"(pA[rr])); p1[rr] = p1[rr] + bA[rr] + pA[rr]; rm = fmaxf(rm, p1[rr]); } }
            rm = pl32_max(rm);
            if (__any(rm > m[hq] + 8.0f)) {
                const float mn = fmaxf(m[hq], rm); const float al = __builtin_amdgcn_exp2f(m[hq] - mn); m[hq] = mn; l[hq] *= al;
                if (hi == 0) wsf[r32] = al;
                LDS_WAIT();
#pragma unroll
                for (int rr = 0; rr < 16; ++rr) { const float f = wsf[crow(rr, hi)]; o[hq][0][rr] *= f; o[hq][1][rr] *= f; }
            }
            { float sm = 0.f; const float mm = m[hq];
#pragma unroll
              for (int rr = 0; rr < 16; ++rr) { if (NA_LIVE0(rr)) { p0[rr] = __builtin_amdgcn_exp2f(p0[rr] - mm); sm += p0[rr]; } else p0[rr] = 0.f;
                  if (NA_LIVE1(rr)) { p1[rr] = __builtin_amdgcn_exp2f(p1[rr] - mm); sm += p1[rr]; } else p1[rr] = 0.f; }
              l[hq] += sm; }
            pack_p(p0, p1, a0, a1, a2, a3);
            { const unsigned va = lds0 + 8192 + vlane; s16x4 xl0, xl1, xl2, xl3, xh0, xh1, xh2, xh3, yl0, yl1, yl2, yl3, yh0, yh1, yh2, yh3;
              asm volatile("s_waitcnt lgkmcnt(0)" ::: "memory");
              if (hq == 0) { if (i < 7) asm volatile("s_waitcnt vmcnt(8)" ::: "memory"); else asm volatile("s_waitcnt vmcnt(0)" ::: "memory"); }
              PV_RD(xl, xh, 0); PV_RD(yl, yh, 1); PV_WAIT(8, xl, xh);
              if (hq == 0) { o[hq][0] = __builtin_amdgcn_mfma_f32_32x32x16_bf16(a0, PV_PK(xl0, xh0), o[hq][0], 0, 0, 0); o[hq][0] = __builtin_amdgcn_mfma_f32_32x32x16_bf16(a1, PV_PK(xl1, xh1), o[hq][0], 0, 0, 0); o[hq][0] = __builtin_amdgcn_mfma_f32_32x32x16_bf16(a2, PV_PK(xl2, xh2), o[hq][0], 0, 0, 0); }
              else { o[hq][0] = __builtin_amdgcn_mfma_f32_32x32x16_bf16(a1, PV_PK(xl1, xh1), o[hq][0], 0, 0, 0); o[hq][0] = __builtin_amdgcn_mfma_f32_32x32x16_bf16(a2, PV_PK(xl2, xh2), o[hq][0], 0, 0, 0); o[hq][0] = __builtin_amdgcn_mfma_f32_32x32x16_bf16(a3, PV_PK(xl3, xh3), o[hq][0], 0, 0, 0); }
              PV_WAIT(0, yl, yh);
              if (hq == 0) { o[hq][1] = __builtin_amdgcn_mfma_f32_32x32x16_bf16(a0, PV_PK(yl0, yh0), o[hq][1], 0, 0, 0); o[hq][1] = __builtin_amdgcn_mfma_f32_32x32x16_bf16(a1, PV_PK(yl1, yh1), o[hq][1], 0, 0, 0); o[hq][1] = __builtin_amdgcn_mfma_f32_32x32x16_bf16(a2, PV_PK(yl2, yh2), o[hq][1], 0, 0, 0); }
              else { o[hq][1] = __builtin_amdgcn_mfma_f32_32x32x16_bf16(a1, PV_PK(yl1, yh1), o[hq][1], 0, 0, 0); o[hq][1] = __builtin_amdgcn_mfma_f32_32x32x16_bf16(a2, PV_PK(yl2, yh2), o[hq][1], 0, 0, 0); o[hq][1] = __builtin_amdgcn_mfma_f32_32x32x16_bf16(a3, PV_PK(yl3, yh3), o[hq][1], 0, 0, 0); } }
#undef NA_LIVE0
#undef NA_LIVE1
        }
        LDS_WAIT();
        if (i < 7) NA_DMA_V(i + 1);
    }
#undef NA_DMA_K
#undef NA_DMA_V
#pragma unroll
    for (int hq = 0; hq < 2; ++hq) {
        const float lt = pl32_sum(l[hq]);
        if (hi == 0) wsf[r32] = 1.0f / lt;
        LDS_WAIT();
        char* Ow = (char*)(mix + (rowbase + (size_t)r * 64 + hq * 32) * D + h * 64);
        int hi2 = hi; asm volatile("" : "+v"(hi2));
        const unsigned ob = (unsigned)((4 * hi2) * D + r32) * 2u;
#pragma unroll
        for (int rr = 0; rr < 16; ++rr) { const unsigned orow = (unsigned)((rr & 3) + 8 * (rr >> 2)); const float f = wsf[orow + 4 * hi2];
#pragma unroll
            for (int d0 = 0; d0 < 2; ++d0) { const float v = o[hq][d0][rr] * f; *(bf16_t*)(Ow + (ob + (orow * D + d0 * 32) * 2u)) = (bf16_t)(cvt_pk_bf16(v, 0.f) & 0xffffu); } }
        LDS_WAIT();
    }
}

constexpr int SGU_SV_OFF = 32768, SGU_SV_PITCH = 144, SGU_ST_OFF = 106496;
__device__ __forceinline__ void sgu_unit(KArgs a, int li, int chunk, LAS unsigned char* lds, int tid, int wid, int lane) {
    unsigned char* ws = a->ws;
    const bf16_t* z = (const bf16_t*)(ws + WS_QKV) + (size_t)chunk * 128 * 2048; bf16_t* mix = (bf16_t*)(ws + WS_MIX) + (size_t)chunk * 128 * D;
    const bf16_t* wsb = (const bf16_t*)(ws + WS_WSB) + (size_t)li * 8 * 128 * 128;
    const float* lng = a->in[I_LNVG] + (size_t)li * D; const float* lnb = a->in[I_LNVB] + (size_t)li * D; const float* bs = a->in[I_BS] + (size_t)li * 8 * 128;
    LAS float* st = (LAS float*)(lds + SGU_ST_OFF); LAS float* svt = (LAS float*)(lds + SGU_SV_OFF);
    const unsigned lds0 = (unsigned)(uintptr_t)lds;
    const int r32 = lane & 31, hi = lane >> 5;
    LAS float* gl = (LAS float*)(lds + SGU_ST_OFF + 1024); LAS float* bl = gl + 1024;
    for (int i = tid; i < 1024; i += NWAVES * 64) { gl[i] = lng[i]; bl[i] = lnb[i]; }
#pragma unroll
    for (int hb = 0; hb < 2; ++hb) {
        u32x4 x0[8], x1[8];
#pragma unroll
        for (int rr = 0; rr < 8; ++rr) { const u32x4* vr = (const u32x4*)(z + (size_t)(wid * 16 + hb * 8 + rr) * 2048 + 1024) + lane * 2; x0[rr] = vr[0]; x1[rr] = vr[1]; }
#pragma unroll
        for (int rr = 0; rr < 8; ++rr) { float f[16];
            f[0] = bf_lo(x0[rr].x); f[1] = bf_hi(x0[rr].x); f[2] = bf_lo(x0[rr].y); f[3] = bf_hi(x0[rr].y); f[4] = bf_lo(x0[rr].z); f[5] = bf_hi(x0[rr].z); f[6] = bf_lo(x0[rr].w); f[7] = bf_hi(x0[rr].w);
            f[8] = bf_lo(x1[rr].x); f[9] = bf_hi(x1[rr].x); f[10] = bf_lo(x1[rr].y); f[11] = bf_hi(x1[rr].y); f[12] = bf_lo(x1[rr].z); f[13] = bf_hi(x1[rr].z); f[14] = bf_lo(x1[rr].w); f[15] = bf_hi(x1[rr].w);
            float sm = 0.f;
#pragma unroll
            for (int k = 0; k < 16; ++k) sm += f[k];
            const float mean = wave_sum_dpp(sm) * (1.f / 1024.f); float s2 = 0.f;
#pragma unroll
            for (int k = 0; k < 16; ++k) { const float d = f[k] - mean; s2 += d * d; }
            const float rstd = 1.f / sqrtf(wave_sum_dpp(s2) * (1.f / 1024.f) + LN_EPS);
            if (lane == 0) { const int row = wid * 16 + hb * 8 + rr; st[row * 2] = mean; st[row * 2 + 1] = rstd; } } }
    __syncthreads();
    const int tb = wid & 3, ch = wid >> 2;
    const int vlane = ((lane >> 4) & 1) * 32 + (lane & 3) * 8 + (4 * hi + ((lane & 15) >> 2)) * 64;
    const int srow = tid >> 2, scq = tid & 3;
    const float mean_s = st[srow * 2], rstd_s = st[srow * 2 + 1];
    const bf16_t* vrow0 = z + (size_t)srow * 2048 + 1024 + scq * 32;
    const bf16_t* wrow0 = wsb + ((size_t)(tb * 32 + r32)) * 128 + 4 * hi;
    u32x4 xv[4]; u32x2 aw[2][4][2];
#define SGU_LOAD(G, XV, AW) do { _Pragma("unroll") for (int q = 0; q < 4; ++q) XV[q] = *((const u32x4*)(vrow0 + (G) * 128) + q); \
        _Pragma("unroll") for (int sl = 0; sl < 2; ++sl) _Pragma("unroll") for (int ks = 0; ks < 4; ++ks) { \
            AW[sl][ks][0] = *(const u32x2*)(wrow0 + (size_t)(G) * 128 * 128 + sl * 64 + ks * 16); AW[sl][ks][1] = *(const u32x2*)(wrow0 + (size_t)(G) * 128 * 128 + sl * 64 + ks * 16 + 8); } } while (0)
    SGU_LOAD(0, xv, aw);
    for (int g = 0; g < 8; ++g) {
#pragma unroll
        for (int q = 0; q < 4; ++q) { const u32x4 x = xv[q]; const int c0 = g * 128 + scq * 32 + q * 8;
            const f32x4 g0 = *(const LAS f32x4*)(gl + c0), g1 = *(const LAS f32x4*)(gl + c0 + 4), b0 = *(const LAS f32x4*)(bl + c0), b1 = *(const LAS f32x4*)(bl + c0 + 4);
            float f[8] = {bf_lo(x.x), bf_hi(x.x), bf_lo(x.y), bf_hi(x.y), bf_lo(x.z), bf_hi(x.z), bf_lo(x.w), bf_hi(x.w)};
#pragma unroll
            for (int k = 0; k < 4; ++k) { f[k] = (f[k] - mean_s) * rstd_s * g0[k] + b0[k]; f[4 + k] = (f[4 + k] - mean_s) * rstd_s * g1[k] + b1[k]; }
            u32x4 w; w.x = cvt_pk_bf16(f[0], f[1]); w.y = cvt_pk_bf16(f[2], f[3]); w.z = cvt_pk_bf16(f[4], f[5]); w.w = cvt_pk_bf16(f[6], f[7]);
            *(LAS u32x4*)(lds + (srow >> 6) * 16384 + (scq * 4 + ((srow & 63) >> 4)) * 1024 + (srow & 15) * 64 + q * 16) = w; }
        u32x4 uu[4];
        { const u32x4* urow = (const u32x4*)(z + (size_t)srow * 2048 + g * 128 + scq * 32);
#pragma unroll
          for (int q = 0; q < 4; ++q) uu[q] = urow[q]; }
        u32x4 xn[4]; u32x2 an[2][4][2];
        if (g + 1 < 8) SGU_LOAD(g + 1, xn, an);
        const float bsv = bs[g * 128 + srow];
        __syncthreads();
        f32x16 o[2]; o[0] = f32x16{}; o[1] = f32x16{};
#pragma unroll
        for (int sl = 0; sl < 2; ++sl) {
            bf16x8 af[4];
#pragma unroll
            for (int ks = 0; ks < 4; ++ks) { u32x4 w = {aw[sl][ks][0].x, aw[sl][ks][0].y, aw[sl][ks][1].x, aw[sl][ks][1].y}; af[ks] = __builtin_bit_cast(bf16x8, w); }
            pv_asm<2>(o, lds0 + sl * 16384 + (2 * ch) * 4096 + vlane, af[0], af[1], af[2], af[3]);
        }
#pragma unroll
        for (int r = 0; r < 16; ++r) { const int t = tb * 32 + crow(r, hi);
#pragma unroll
            for (int d0 = 0; d0 < 2; ++d0) svt[t * SGU_SV_PITCH + ch * 64 + d0 * 32 + r32] = o[d0][r]; }
        __syncthreads();
        { const LAS f32x4* sp = (const LAS f32x4*)(svt + srow * SGU_SV_PITCH + scq * 32);
          u32x4* orow = (u32x4*)(mix + (size_t)srow * D + g * 128 + scq * 32);
#pragma unroll
          for (int q = 0; q < 4; ++q) { const f32x4 s0 = sp[2 * q], s1 = sp[2 * q + 1]; const u32x4 u = uu[q];
              u32x4 w; w.x = cvt_pk_bf16(bf_lo(u.x) * (s0[0] + bsv), bf_hi(u.x) * (s0[1] + bsv)); w.y = cvt_pk_bf16(bf_lo(u.y) * (s0[2] + bsv), bf_hi(u.y) * (s0[3] + bsv));
              w.z = cvt_pk_bf16(bf_lo(u.z) * (s1[0] + bsv), bf_hi(u.z) * (s1[1] + bsv)); w.w = cvt_pk_bf16(bf_lo(u.w) * (s1[2] + bsv), bf_hi(u.w) * (s1[3] + bsv));
              orow[q] = w; } }
#pragma unroll
        for (int q = 0; q < 4; ++q) xv[q] = xn[q];
#pragma unroll
        for (int sl = 0; sl < 2; ++sl)
#pragma unroll
            for (int ks = 0; ks < 4; ++ks) { aw[sl][ks][0] = an[sl][ks][0]; aw[sl][ks][1] = an[sl][ks][1]; }
    }
#undef SGU_LOAD
    __syncthreads();
}

constexpr int PH_PER_LAYER = 9, N_PHASES = 1 + DEPTH * PH_PER_LAYER;
__global__ void __launch_bounds__(NWAVES * 64, 2) enc_fwd(Args args) {
    extern __shared__ __attribute__((aligned(16))) unsigned char lds_raw[];
    LAS unsigned char* lds = (LAS unsigned char*)lds_raw;
    volatile LAS unsigned* MISC = (volatile LAS unsigned*)(lds + MISC_OFF);
    const int tid = threadIdx.x, lane = tid & 63, wave = __builtin_amdgcn_readfirstlane(tid >> 6);
    const int G = gridDim.x; const int bx = blockIdx.x; const int vcu = (G % 8 == 0) ? (bx % 8) * (G / 8) + bx / 8 : bx;
    const int gw = vcu * NWAVES + wave, NGW = G * NWAVES;
    unsigned char* ws = args.ws;
    unsigned* ctl = (unsigned*)(ws + WS_CTL);
    for (int u = tid; u < 256; u += NWAVES * 64) ((LAS unsigned*)(lds + MISC_OFF))[u] = 0u;
    __syncthreads();
    XcdBarrier bar; bar.bar = ctl + CW_BAR; bar.x = 0; bar.st = nullptr;
#if !MK_PER_PHASE
    bar = xcd_barrier_post(ctl + CW_BAR, MISC + 8);
#define GRID_BAR() xcd_barrier(bar)
#else
#define GRID_BAR() do { } while (0)
#endif
    const int lo = args.ph_lo, hi = args.ph_hi;
#ifndef PH_MASK
#define PH_MASK 0xffffffffu
#endif
#define PHON(s) ((PH_MASK >> (s)) & 1u)
#ifndef REP_MASK
#define REP_MASK 0u
#endif
#define REPN(s) (((REP_MASK >> (s)) & 1u) ? 2 : 1)
#define IN(k) (lo <= (k) && (k) < hi)
#define SEAM(k) do { if (IN(k) && IN((k) + 1)) GRID_BAR(); } while (0)
#define XB ((bf16_t*)(ws_ + WS_XB))
#define QKV ((bf16_t*)(ws_ + WS_QKV))
#define MIX ((bf16_t*)(ws_ + WS_MIX))
#define HM ((bf16_t*)(ws_ + WS_HM))
#define HEXP ((bf16_t*)(ws_ + WS_HEXP))
#define YEXP ((bf16_t*)(ws_ + WS_QKV))

#define PH_IDS KArgs A = (KArgs)__builtin_amdgcn_kernarg_segment_ptr(); asm volatile("" : "+s"(A)); unsigned char* ws_ = A->ws; (void)ws_; int tid_ = tid; asm volatile("" : "+v"(tid_)); const int lane_ = tid_ & 63; int wave_ = wave; asm volatile("" : "+s"(wave_)); (void)lane_; (void)wave_;
    if (PHON(0) && IN(0)) { PH_IDS phase_prologue(A, lds, gw, NGW, wave_, lane_); } SEAM(0);

    for (int l = 0; l < DEPTH; ++l) {
        const int pb = 1 + l * PH_PER_LAYER; const int li = l >> 1;
        if ((l & 1) == 0) {
            if (PHON(1) && IN(pb + 0)) for (int rep_ = 0; rep_ < REPN(1); ++rep_) { if (rep_) __syncthreads(); PH_IDS pg8::Gemm g{XB, (const bf16_t*)(ws_ + WS_WINAB) + (size_t)li * QKVW * D, T, QKVW, D, nullptr, QKVW}; pg8::StaticOrder S; S.init(T, QKVW, G, bx);
                pg8::EpiBf16<2> E{QKV, QKVW}; pg8::gemm_phase<pg8::EpiBf16<2>, pg8::StaticOrder, false>(lds, g, S, E, tid_); }
            SEAM(pb + 0);
            if (IN(pb + 1)) for (int rep_ = 0; rep_ < REPN(2); ++rep_) {
                if (rep_) __syncthreads();
                PH_IDS
                { const float* rp = A->in[I_RPB] + (size_t)li * 8 * 465; LAS float* rl = (LAS float*)(lds + RPB_OFF);
                  constexpr int NTR = (NA_PEN + 128 + NWAVES * 64 - 1) / (NWAVES * 64); float tv[NTR];
#pragma unroll
                  for (int u = 0; u < NTR; ++u) { const int i = tid_ + u * (NWAVES * 64); int ix = i - NA_PADB; ix = ix < 0 ? 0 : (ix > 8 * 465 - 1 ? 8 * 465 - 1 : ix); tv[u] = rp[ix]; }
#pragma unroll
                  for (int u = 0; u < NTR; ++u) { const int i = tid_ + u * (NWAVES * 64); float v = 0.f;
                      if (i >= NA_PADB && i < NA_PADB + 8 * 465) v = tv[u] * LOG2E;
                      else if (i >= NA_PEN) { const int t = i - NA_PEN - 48; v = (t >= 0 && t <= 15) ? 0.f : -1e30f; }
                      if (i < NA_PEN + 128) rl[i] = v; } }
                __syncthreads();
                phase_key_norms(QKV, (float*)(ws_ + WS_KN), gw, NGW, lane_);
                asm volatile("s_waitcnt vmcnt(0)" ::: "memory"); __syncthreads();
                if (tid_ == 0) { __builtin_amdgcn_fence(__ATOMIC_RELEASE, "agent"); __hip_atomic_fetch_add((unsigned*)(ws_ + WS_CTL) + 3072 + 64 * li, 1u, __ATOMIC_RELAXED, __HIP_MEMORY_SCOPE_AGENT); }
                if (PHON(2)) for (int u = vcu; u < 512; u += G) natten_unit(QKV, MIX, u >> 7, u & 127, lds, wave_, lane_);
                __syncthreads();
            }
            if (PHON(3) && IN(pb + 2)) for (int rep_ = 0; rep_ < REPN(3); ++rep_) {
                if (rep_) __syncthreads();
                PH_IDS
                const float* lq = A->in[I_LAMQK] + (size_t)li * 256;
                const float d1 = wave_sum(lq[lane_] * lq[64 + lane_]), d2 = wave_sum(lq[128 + lane_] * lq[192 + lane_]);
                const float lam_init = (li == 0) ? 0.2f : (float)(0.8 - 0.6 * 0.54881163609402643);
                const float lam = uni_f(__expf(d1) - __expf(d2) + lam_init);
                unsigned* qhead = (unsigned*)(ws_ + WS_CTL) + 2048 + 64 * li;
                constexpr int NCONV = 8;
                const bool conv_first = vcu >= G - NCONV;
                if (conv_first && PHON(10)) { phase_moe_convert(A, l, lds, gw, NGW, wave_, lane_); if (l + 1 < DEPTH) phase_moe_convert(A, l + 1, lds, gw, NGW, wave_, lane_); __syncthreads(); }
                if (tid_ == 0) { unsigned* kc = (unsigned*)(ws_ + WS_CTL) + 3072 + 64 * li; unsigned sp = 0;
                    while (__hip_atomic_load(kc, __ATOMIC_RELAXED, __HIP_MEMORY_SCOPE_AGENT) < (unsigned)G) { __builtin_amdgcn_s_sleep(1); if (++sp > XB_SPIN_CAP) break; }
                    __builtin_amdgcn_fence(__ATOMIC_ACQUIRE, "agent"); }
                __syncthreads();
                unsigned nxt = 0; if (tid_ == 0) nxt = __builtin_amdgcn_atomic_inc32(qhead, 0xffffffffu, __ATOMIC_RELAXED, "agent");
                _Pragma("nounroll") for (;;) {
                    LAS int* qs = (LAS int*)(lds + MISC_OFF + 512);
                    if (tid_ == 0) qs[0] = (int)nxt;
                    __syncthreads();
                    const int u = __builtin_amdgcn_readfirstlane(qs[0]);
                    __syncthreads();
                    if (u >= 1024) break;
                    if (tid_ == 0) nxt = __builtin_amdgcn_atomic_inc32(qhead, 0xffffffffu, __ATOMIC_RELAXED, "agent");
                    const int h = 3 - (u >> 8), b = (u >> 6) & 3, qb = u & 63;
                    const float slope = uni_f(__uint_as_float((unsigned)(127 - 2 * (h + 1)) << 23));
                    diff_attn_unit(QKV, MIX, (const float*)(ws_ + WS_KN), b, h, qb, lam, uni_f(slope * LOG2E), A->in[I_SUBLN] + (size_t)li * 512, 1.0f - lam_init, lds, tid_, wave_, lane_); }
                if (!conv_first && PHON(10)) { __syncthreads(); phase_moe_convert(A, l, lds, gw, NGW, wave_, lane_); if (l + 1 < DEPTH) phase_moe_convert(A, l + 1, lds, gw, NGW, wave_, lane_); __syncthreads(); }
            }
            SEAM(pb + 2);
            if (PHON(4) && IN(pb + 3)) for (int rep_ = 0; rep_ < REPN(4); ++rep_) { if (rep_) __syncthreads(); PH_IDS pg8::Gemm g{MIX, (const bf16_t*)(ws_ + WS_WOUTAB) + (size_t)li * D * D, T, D, D, nullptr, D}; pg8::StaticOrder S; S.init(T, D, G, bx);
                pg8::EpiBf16<0> E{HM, D}; pg8::gemm_phase<pg8::EpiBf16<0>, pg8::StaticOrder, false>(lds, g, S, E, tid_); }
            SEAM(pb + 3);
        } else {
            if (PHON(5) && IN(pb + 0)) for (int rep_ = 0; rep_ < REPN(5); ++rep_) { if (rep_) __syncthreads(); PH_IDS pg8::Gemm g{XB, (const bf16_t*)(ws_ + WS_WINC) + (size_t)li * 2048 * D, T, 2048, D, nullptr, 2048}; pg8::StaticOrder S; S.init(T, 2048, G, bx);
                pg8::EpiBf16<1> E{QKV, 2048}; pg8::gemm_phase<pg8::EpiBf16<1>, pg8::StaticOrder, false>(lds, g, S, E, tid_); }
            SEAM(pb + 0);
            if (PHON(6) && IN(pb + 1)) for (int rep_ = 0; rep_ < REPN(6); ++rep_) { if (rep_) __syncthreads(); PH_IDS for (int u = vcu; u < T / 128; u += G) sgu_unit(A, li, u, lds, tid_, wave_, lane_); }
            SEAM(pb + 1);
            if (PHON(7) && IN(pb + 3)) for (int rep_ = 0; rep_ < REPN(7); ++rep_) { if (rep_) __syncthreads(); PH_IDS pg8::Gemm g{MIX, (const bf16_t*)(ws_ + WS_WOUTC) + (size_t)li * D * D, T, D, D, nullptr, D}; pg8::StaticOrder S; S.init(T, D, G, bx);
                pg8::EpiBf16<0> E{HM, D}; pg8::gemm_phase<pg8::EpiBf16<0>, pg8::StaticOrder, false>(lds, g, S, E, tid_); }
            SEAM(pb + 3);
        }
        if (PHON(8) && IN(pb + 4)) for (int rep_ = 0; rep_ < ((l == 0) ? REPN(8) : 1); ++rep_) { PH_IDS phase_ln_router<false>(A, l, lds, gw, NGW, tid_, lane_);
            asm volatile("s_waitcnt vmcnt(0)" ::: "memory"); __syncthreads();
            if (tid_ == 0) { __builtin_amdgcn_fence(__ATOMIC_RELEASE, "agent"); __hip_atomic_fetch_add((unsigned*)(ws_ + WS_CTL) + 3200 + 64 * l, 1u, __ATOMIC_RELAXED, __HIP_MEMORY_SCOPE_AGENT); } }
        if (IN(pb + 5)) for (int rep_ = 0; rep_ < REPN(9); ++rep_) { if (rep_) __syncthreads(); PH_IDS
            if (PHON(9) && vcu < BATCH * NE) {
                if (tid_ == 0) { unsigned* rc = (unsigned*)(ws_ + WS_CTL) + 3200 + 64 * l; unsigned sp = 0;
                    while (__hip_atomic_load(rc, __ATOMIC_RELAXED, __HIP_MEMORY_SCOPE_AGENT) < (unsigned)G) { __builtin_amdgcn_s_sleep(1); if (++sp > XB_SPIN_CAP) break; }
                    __builtin_amdgcn_fence(__ATOMIC_ACQUIRE, "agent"); }
                __syncthreads();
                for (int u = vcu; u < BATCH * NE; u += G) topk_unit(A, u, lds, tid_, wave_, lane_); }
            __syncthreads(); }
        SEAM(pb + 5);
        if (PHON(11) && IN(pb + 6)) for (int rep_ = 0; rep_ < REPN(11); ++rep_) { if (rep_) __syncthreads(); PH_IDS pg8::Gemm g{XB, (const bf16_t*)(ws_ + WS_WGU + (size_t)(l & 1) * WS_WDELTA), NE * EROWS, NE * 4096, D, (const int*)(ws_ + WS_SELT), 4096}; pg8::XcdExpertOrder S; S.init(EROWS / 256, 4096 / 256, G, bx);
            pg8::EpiSwiGLU E{HEXP}; pg8::gemm_phase<pg8::EpiSwiGLU, pg8::XcdExpertOrder, true>(lds, g, S, E, tid_); }
        SEAM(pb + 6);
        if (PHON(12) && IN(pb + 7)) for (int rep_ = 0; rep_ < REPN(12); ++rep_) { if (rep_) __syncthreads(); PH_IDS pg8::Gemm g{HEXP, (const bf16_t*)(ws_ + WS_WD + (size_t)(l & 1) * WS_WDELTA), NE * EROWS, NE * D, DEXP, nullptr, D}; pg8::XcdExpertOrder S; S.init(EROWS / 256, D / 256, G, bx, 2, 1);
            pg8::EpiDown E{YEXP, (const float*)(ws_ + WS_SELG)}; pg8::gemm_phase<pg8::EpiDown, pg8::XcdExpertOrder, false, true>(lds, g, S, E, tid_); }
        SEAM(pb + 7);
        if (PHON(13) && IN(pb + 8)) for (int rep_ = 0; rep_ < ((l == DEPTH - 1) ? REPN(13) : 1); ++rep_) { PH_IDS phase_combine_ln(A, l, gw, NGW, lane_); }
        SEAM(pb + 8);
    }
#undef IN
#undef SEAM
#undef XB
#undef QKV
#undef MIX
#undef HM
#undef HEXP
#undef YEXP
}

extern "C" void kernel_launch(void* const* d_in, const int* in_sizes, int n_in, void* d_out, int out_size, void* d_ws, size_t ws_size, hipStream_t stream) {
    static int grid = 0;
    if (grid == 0) {
        if (n_in != 20 || out_size != T * D || ws_size < WS_END) { fprintf(stderr, "kernel_launch: unexpected shapes (n_in %d out %d ws %zu, need %zu)\n", n_in, out_size, ws_size, (size_t)WS_END); grid = -1; return; }
        int dev = 0, cus = 0, per_cu = 0;
        if (hipGetDevice(&dev) != hipSuccess || hipDeviceGetAttribute(&cus, hipDeviceAttributeMultiprocessorCount, dev) != hipSuccess) { grid = -1; return; }
        if (hipFuncSetAttribute((const void*)enc_fwd, hipFuncAttributeMaxDynamicSharedMemorySize, LDS_BYTES) != hipSuccess) { fprintf(stderr, "kernel_launch: hipFuncSetAttribute failed\n"); grid = -1; return; }
        if (hipOccupancyMaxActiveBlocksPerMultiprocessor(&per_cu, (const void*)enc_fwd, NWAVES * 64, LDS_BYTES) != hipSuccess || per_cu < 1) fprintf(stderr, "kernel_launch: occupancy query reports %d\n", per_cu);
        (void)hipGetLastError();
        grid = cus;
    }
    if (grid < 0) return;
    if (hipMemsetAsync((char*)d_ws + WS_CTL, 0, CTL_ZERO_BYTES, stream) != hipSuccess) return;
    Args a{};
    for (int i = 0; i < 20; ++i) a.in[i] = (const float*)d_in[i];
    a.out = (float*)d_out; a.ws = (unsigned char*)d_ws;
#if MK_PER_PHASE
    for (int p = 0; p < N_PHASES; ++p) { a.ph_lo = p; a.ph_hi = p + 1; hipLaunchKernelGGL(enc_fwd, dim3(grid), dim3(NWAVES * 64), LDS_BYTES, stream, a); }
#else
    a.ph_lo = 0; a.ph_hi = N_PHASES;
    hipLaunchKernelGGL(enc_fwd, dim3(grid), dim3(NWAVES * 64), LDS_BYTES, stream, a);
#endif
    const hipError_t le = hipPeekAtLastError();
    if (le != hipSuccess) fprintf(stderr, "kernel_launch: launch failed: %s\n", hipGetErrorName(le));
}
```

```cpp
#include <hip/hip_runtime.h>
#include <hip/hip_bf16.h>
#include <cstdio>
#include <cstdint>

#ifndef MK_PER_PHASE
#define MK_PER_PHASE 0
#endif

constexpr int D = 1024, BATCH = 4, SEQ = 8192, T = BATCH * SEQ, DEPTH = 4;
constexpr int NE = 16, CAP = 1024, DEXP = 2048, EROWS = BATCH * CAP;
constexpr int QKVW = 3072;
constexpr float LN_EPS = 1e-5f, RMS_EPS = 1e-6f;
constexpr float ALPHA = 1.6817928305074290f;
constexpr float LOG2E = 1.4426950408889634f;
constexpr float C2Q = 0.125f * LOG2E;
constexpr int NWAVES = 8;

constexpr size_t MiB = 1u << 20;
constexpr size_t WS_CTL = 0, CTL_ZERO_BYTES = 32 * 1024;
constexpr size_t WS_WINAB = 1 * MiB;
constexpr size_t WS_WOUTAB = WS_WINAB + 12 * MiB;
constexpr size_t WS_WINC = WS_WOUTAB + 4 * MiB;
constexpr size_t WS_WOUTC = WS_WINC + 8 * MiB;
constexpr size_t WS_WSB = WS_WOUTC + 4 * MiB;
constexpr size_t WS_AFFT = WS_WSB + 1 * MiB;
constexpr size_t WS_INV = WS_AFFT + 2 * MiB;
constexpr size_t WS_SELT = WS_INV + 2 * MiB;
constexpr size_t WS_SELG = WS_SELT + 256 * 1024;
constexpr size_t WS_WGU = 36 * MiB;
constexpr size_t WS_WD = WS_WGU + 128 * MiB;
constexpr size_t WS_XF = WS_WD + 64 * MiB;
constexpr size_t WS_XB = WS_XF + 128 * MiB;
constexpr size_t WS_QKV = WS_XB + 64 * MiB;
constexpr size_t WS_MIX = WS_QKV + 192 * MiB;
constexpr size_t WS_HM = WS_MIX + 64 * MiB;
constexpr size_t WS_HEXP = WS_HM + 64 * MiB;
constexpr size_t WS_W2 = WS_HEXP + 256 * MiB;
constexpr size_t WS_WDELTA = WS_W2 - WS_WGU;
constexpr size_t WS_END = WS_W2 + 192 * MiB;
constexpr size_t WS_KN = WS_SELG + 256 * 1024;
static_assert(WS_KN + 8192 <= WS_WGU, "ws map");

constexpr int CW_TMO = 0;
constexpr int CW_BAR = 4096;

constexpr int RING_BYTES = 133120;
constexpr int MISC_OFF = RING_BYTES;
constexpr int SCR_OFF = MISC_OFF + 1024;
constexpr int RPB_OFF = SCR_OFF + 4096;
constexpr int LDS_BYTES = RPB_OFF + 17408;
constexpr int NA_PADB = 64, NA_PEN = NA_PADB + 8 * 465 + 64;
static_assert(LDS_BYTES <= 160 * 1024, "LDS");

#define GAS __attribute__((address_space(1)))
#define LAS __attribute__((address_space(3)))
typedef unsigned short bf16_t;
typedef short bf16x8 __attribute__((ext_vector_type(8)));
typedef short s16x4 __attribute__((ext_vector_type(4)));
typedef float f32x4 __attribute__((ext_vector_type(4)));
typedef float f32x2 __attribute__((ext_vector_type(2)));
typedef float f32x16 __attribute__((ext_vector_type(16)));
typedef unsigned u32x4 __attribute__((ext_vector_type(4)));
typedef unsigned u32x2 __attribute__((ext_vector_type(2)));
#define RLX_AGENT __ATOMIC_RELAXED, __HIP_MEMORY_SCOPE_AGENT

__device__ __forceinline__ unsigned cvt_pk_bf16(float lo, float hi) { unsigned r; asm volatile("v_cvt_pk_bf16_f32 %0, %1, %2" : "=v"(r) : "v"(lo), "v"(hi)); return r; }
__device__ __forceinline__ float bf_lo(unsigned w) { return __uint_as_float(w << 16); }
__device__ __forceinline__ float bf_hi(unsigned w) { return __uint_as_float(w & 0xffff0000u); }
template <int X> __device__ __forceinline__ float swz_xor(float v) { return __builtin_bit_cast(float, __builtin_amdgcn_ds_swizzle(__builtin_bit_cast(int, v), (X << 10) | 0x1f)); }
__device__ __forceinline__ float half_sum(float v) { v += swz_xor<1>(v); v += swz_xor<2>(v); v += swz_xor<4>(v); v += swz_xor<8>(v); v += swz_xor<16>(v); return v; }
__device__ __forceinline__ float wave_max(float v) { v = fmaxf(v, swz_xor<1>(v)); v = fmaxf(v, swz_xor<2>(v)); v = fmaxf(v, swz_xor<4>(v)); v = fmaxf(v, swz_xor<8>(v)); v = fmaxf(v, swz_xor<16>(v));
    auto rr = __builtin_amdgcn_permlane32_swap(__float_as_uint(v), __float_as_uint(v), false, false); return fmaxf(__uint_as_float(rr[0]), __uint_as_float(rr[1])); }
template <int CTRL, int RM> __device__ __forceinline__ float dpp_add(float v) { return v + __builtin_bit_cast(float, __builtin_amdgcn_update_dpp(0, __builtin_bit_cast(int, v), CTRL, RM, 0xf, false)); }
__device__ __forceinline__ float wave_sum_dpp(float v) {
    v = dpp_add<0xB1, 0xf>(v); v = dpp_add<0x4E, 0xf>(v); v = dpp_add<0x141, 0xf>(v); v = dpp_add<0x140, 0xf>(v); v = dpp_add<0x142, 0xa>(v); v = dpp_add<0x143, 0xc>(v);
    return __builtin_bit_cast(float, __builtin_amdgcn_readlane(__builtin_bit_cast(int, v), 63));
}
__device__ __forceinline__ float wave_sum(float v) {
    v = half_sum(v);
    auto rr = __builtin_amdgcn_permlane32_swap(__float_as_uint(v), __float_as_uint(v), false, false); return __uint_as_float(rr[0]) + __uint_as_float(rr[1]);
}

namespace pg8 {
constexpr int BM = 256, BK = 64, HALF = 128, HTB = HALF * BK * 2, STAGE_BYTES = 8 * HTB, NXCD = 8, WGM = 8;
__host__ __device__ __forceinline__ int lds_byte(int r, int c) { const int st = (r >> 4) * 2 + (c >> 5), rr = r & 15, cc = c & 31, ob = rr * 64 + cc * 2; return st * 1024 + (ob ^ (((ob >> 9) & 1) << 5)); }
__host__ __device__ __forceinline__ void stage_rc(int b, int& R, int& C) { const int st = b / 1024, sb = b % 1024, swz = sb ^ (((sb >> 9) & 1) << 5); R = (st >> 1) * 16 + swz / 64; C = (st & 1) * 32 + (swz % 64) / 2; }
__host__ __device__ __forceinline__ int a_sw(int R) { return ((R >> 1) & 7) ^ (((R + 4) >> 3) & 1); }
__host__ __device__ __forceinline__ int a_byte(int R, int c8) { return (R >> 3) * 1024 + (R & 7) * 128 + ((c8 ^ a_sw(R)) << 4); }
__host__ __device__ __forceinline__ void a_stage_rc(int tid, int i, int& R, int& C) { const int l = tid & 63; R = 8 * ((tid >> 6) + 8 * i) + (l >> 3); C = 8 * ((l & 7) ^ a_sw(R)); }
__host__ __device__ __forceinline__ int perm32(int rho) { const int n = rho >> 4, i = rho & 15; return 8 * (i >> 2) + 4 * n + (i & 3); }

struct Unit { int pm, pn; };
struct Gemm { const bf16_t* A; const bf16_t* Bt; int M, N, K; const int* gidx; int NB; };

struct StaticOrder {
    int nM, nN, nwg, G, c;
    __device__ void init(int M, int N, int G_, int c_) { nM = M / BM; nN = N / BM; nwg = nM * nN; G = G_; c = c_; }
    __device__ bool next(int i, Unit& u) const {
        const long L = (long)i * G + c; if (L >= nwg) return false;
        int wgid = (int)L; { const int q = nwg / NXCD, r = nwg % NXCD, xcd = wgid % NXCD, off = wgid / NXCD; wgid = (xcd < r ? xcd * (q + 1) : r * (q + 1) + (xcd - r) * q) + off; }
        const int nig = WGM * nN, gid = wgid / nig, fm = gid * WGM, gsz = (nM - fm) < WGM ? (nM - fm) : WGM;
        u.pm = fm + ((wgid % nig) % gsz); u.pn = (wgid % nig) / gsz; return true;
    }
};
struct GroupedOrder {
    int mt, nt, upe, G, c, wgm, rev;
    __device__ void init(int mt_, int nt_, int G_, int c_, int wgm_ = WGM, int rev_ = 0) { mt = mt_; nt = nt_; upe = mt_ * nt_; G = G_; c = c_; wgm = wgm_; rev = rev_; }
    __device__ bool next(int i, Unit& u) const {
        const long L = (long)i * G + c; if (L >= (long)NE * upe) return false;
        const int e0 = (int)(L / upe); const int e = rev ? NE - 1 - e0 : e0; int wgid = (int)(L % upe);
        { const int q = upe / NXCD, xcd = wgid % NXCD, off = wgid / NXCD; wgid = xcd * q + off; }
        const int nig = wgm * nt, gid = wgid / nig, fm = gid * wgm, gsz = (mt - fm) < wgm ? (mt - fm) : wgm;
        u.pm = e * mt + fm + ((wgid % nig) % gsz); u.pn = e * nt + (wgid % nig) / gsz; return true;
    }
};

struct XcdExpertOrder {
    int mt, nt, G, c, rev; GroupedOrder fb;
    __device__ void init(int mt_, int nt_, int G_, int c_, int wgm_ = WGM, int rev_ = 0) { mt = mt_; nt = nt_; G = G_; c = c_; rev = rev_; fb.init(mt_, nt_, G_, c_, wgm_, rev_); }
    __device__ bool next(int i0, Unit& u) const {
        if (G != 256 || mt != 16 || (nt & 3)) return fb.next(i0, u);
        const int rpe = (mt * nt) >> 5;
        if (i0 >= 2 * rpe) return false;
        const int i = rev ? 2 * rpe - 1 - i0 : i0;
        const int x = c & 7, r = c >> 3, e = 2 * x + i / rpe, ii = i % rpe;
        u.pm = e * mt + 8 * (ii & 1) + (r >> 2); u.pn = e * nt + 4 * (ii >> 1) + (r & 3); return true;
    }
};

__device__ __forceinline__ f32x2 gelu_pk(f32x2 v) {
    const f32x2 av = __builtin_elementwise_abs(v), d = av * 0.2316418882f + 1.0f;
    f32x2 t; t.x = __builtin_amdgcn_rcpf(d.x); t.y = __builtin_amdgcn_rcpf(d.y);
    f32x2 q = t * 0.5307027145f + (-0.7265760135f); q = q * t + 0.7107068705f; q = q * t + (-0.142248368f); q = q * t + 0.127414796f; q = q * t;
    const f32x2 s = (v * v) * (-0.72134752044f);
    f32x2 e; e.x = __builtin_amdgcn_exp2f(s.x); e.y = __builtin_amdgcn_exp2f(s.y);
    const f32x2 m = v * (q * e), r = v - m;
    f32x2 o; o.x = v.x < 0.f ? m.x : r.x; o.y = v.y < 0.f ? m.y : r.y; return o;
}
__device__ __forceinline__ float silu_f(float g) { return g * __builtin_amdgcn_rcpf(1.0f + __builtin_amdgcn_exp2f(-g * LOG2E)); }

template <int MODE> struct EpiBf16 {
    static constexpr bool PERM = true, ROWSCALE = false;
    bf16_t* O; int ldc;
    __device__ __forceinline__ void operator()(const f32x4 (&acc)[2][2][4][2], const Unit& u, int wr, int wc, int fr, int fq) const {
        const int row0 = u.pm * BM + wr * 64 + fr; const int col0 = u.pn * BM + wc * 32 + 8 * fq;
        float sc = 1.f; if (MODE == 2) { if (u.pn < 2 || u.pn == 6 || u.pn == 7) sc = C2Q; }
#pragma unroll
        for (int ai = 0; ai < 2; ++ai)
#pragma unroll
            for (int m = 0; m < 4; ++m) { bf16_t* rowp = O + (size_t)(row0 + ai * HALF + m * 16) * ldc + col0;
#pragma unroll
                for (int bj = 0; bj < 2; ++bj) { f32x4 v0 = acc[ai][bj][m][0], v1 = acc[ai][bj][m][1];
                    if (MODE == 1) { f32x2 a = gelu_pk((f32x2){v0[0], v0[1]}), b = gelu_pk((f32x2){v0[2], v0[3]}), c = gelu_pk((f32x2){v1[0], v1[1]}), d = gelu_pk((f32x2){v1[2], v1[3]});
                        v0 = (f32x4){a.x, a.y, b.x, b.y}; v1 = (f32x4){c.x, c.y, d.x, d.y}; }
                    if (MODE == 2) { v0 = v0 * sc; v1 = v1 * sc; }
                    u32x4 w; w.x = cvt_pk_bf16(v0[0], v0[1]); w.y = cvt_pk_bf16(v0[2], v0[3]); w.z = cvt_pk_bf16(v1[0], v1[1]); w.w = cvt_pk_bf16(v1[2], v1[3]);
                    *(u32x4*)(rowp + bj * HALF) = w; } }
    }
};
struct EpiSwiGLU {
    static constexpr bool PERM = true, ROWSCALE = false;
    bf16_t* H;
    __device__ __forceinline__ void operator()(const f32x4 (&acc)[2][2][4][2], const Unit& u, int wr, int wc, int fr, int fq) const {
        char* base = (char*)H + ((size_t)(u.pm * 2) * 32 + (size_t)((u.pn & 15) * 2 + (wc >> 1))) * 16384;
        const unsigned loff = (unsigned)a_byte(wr * 64 + fr, (wc & 1) * 4 + fq);
#pragma unroll
        for (int ai = 0; ai < 2; ++ai)
#pragma unroll
            for (int m = 0; m < 4; ++m) {
                const f32x4 g0 = acc[ai][0][m][0], g1 = acc[ai][0][m][1], u0 = acc[ai][1][m][0], u1 = acc[ai][1][m][1];
                u32x4 w; w.x = cvt_pk_bf16(silu_f(g0[0]) * u0[0], silu_f(g0[1]) * u0[1]); w.y = cvt_pk_bf16(silu_f(g0[2]) * u0[2], silu_f(g0[3]) * u0[3]);
                w.z = cvt_pk_bf16(silu_f(g1[0]) * u1[0], silu_f(g1[1]) * u1[1]); w.w = cvt_pk_bf16(silu_f(g1[2]) * u1[2], silu_f(g1[3]) * u1[3]);
                *(u32x4*)(base + (size_t)(loff + (unsigned)(ai * 32 * 16384 + m * 2048))) = w; }
    }
};
struct EpiDown {
    static constexpr bool PERM = true, ROWSCALE = true;
    bf16_t* Y; const float* gate;
    __device__ __forceinline__ void operator()(const f32x4 (&acc)[2][2][4][2], const Unit& u, int wr, int wc, int fr, int fq, const LAS float* rs) const {
        const int row0 = u.pm * BM + wr * 64 + fr; const int col0 = (u.pn & 3) * BM + wc * 32 + 8 * fq;
#pragma unroll
        for (int ai = 0; ai < 2; ++ai)
#pragma unroll
            for (int m = 0; m < 4; ++m) { const int row = row0 + ai * HALF + m * 16; const float gv = rs[wr * 64 + fr + ai * HALF + m * 16]; bf16_t* rowp = Y + (size_t)row * D + col0;
#pragma unroll
                for (int bj = 0; bj < 2; ++bj) { const f32x4 v0 = acc[ai][bj][m][0] * gv, v1 = acc[ai][bj][m][1] * gv;
                    u32x4 w; w.x = cvt_pk_bf16(v0[0], v0[1]); w.y = cvt_pk_bf16(v0[2], v0[3]); w.z = cvt_pk_bf16(v1[0], v1[1]); w.w = cvt_pk_bf16(v1[2], v1[3]);
                    *(u32x4*)(rowp + bj * HALF) = w; } }
    }
};

template <class Epi, class Sched, bool GATHER, bool AIMG = false>
__device__ __forceinline__ void gemm_phase(LAS unsigned char* lds, const Gemm g, const Sched& S, const Epi& E, const int tid) {
    const int wid = __builtin_amdgcn_readfirstlane(tid >> 6), lane = tid & 63, wr = wid >> 2, wc = wid & 3, fr = lane & 15, fq = lane >> 4;
    const int K = g.K, nt = K / BK;
    unsigned voffA[2], voffB[2];
#pragma unroll
    for (int i = 0; i < 2; ++i) { int R, C; a_stage_rc(tid, i, R, C);
        static_assert(Epi::PERM, "the image-ordered B storage carries the PERM row permutation");
        voffA[i] = AIMG ? (unsigned)(tid * 16 + i * 8192) : (unsigned)(R * K + C) * 2u; voffB[i] = (unsigned)(tid * 16 + i * 8192); }
#define PG8_GOFF(pm_, o00, o01, o10, o11) do { const int* _gi = g.gidx + (pm_) * BM; int _R0, _C0, _R1, _C1; a_stage_rc(tid, 0, _R0, _C0); a_stage_rc(tid, 1, _R1, _C1); \
        o00 = ((unsigned)_gi[_R0] * (unsigned)K + (unsigned)_C0) * 2u; o01 = ((unsigned)_gi[_R1] * (unsigned)K + (unsigned)_C1) * 2u; \
        o10 = ((unsigned)_gi[HALF + _R0] * (unsigned)K + (unsigned)_C0) * 2u; o11 = ((unsigned)_gi[HALF + _R1] * (unsigned)K + (unsigned)_C1) * 2u; } while (0)
    const size_t kstep = (size_t)(BK * 2);
    const size_t hstep = (size_t)HALF * K * 2;
    const size_t tstep = 2 * hstep;
    const size_t kstepB = 16384, hstepB = hstep, kstepA = AIMG ? (size_t)16384 : kstep;
#define PG8_BBASE(pn_) ((const char*)g.Bt + (size_t)(pn_) * tstep)
    const unsigned ldsw = (unsigned)wid * 1024u;
    const int aoffk[2] = {a_byte(wr * 64 + fr, fq), a_byte(wr * 64 + fr, fq + 4)}; const int boff = lds_byte(wc * 32 + fr, fq * 8);
#define PG8_SA(b, h) (((b) * 2 + (h)) * HTB)
#define PG8_SB(b, h) ((4 + (b) * 2 + (h)) * HTB)
#define PG8_STAGE(bufoff, gbase, voff) do { _Pragma("unroll") for (int _i = 0; _i < 2; ++_i) \
        __builtin_amdgcn_global_load_lds((const unsigned*)((const char*)(gbase) + (voff)[_i]), (LAS unsigned*)(lds + (bufoff) + ldsw + _i * 8192), 16, 0, 0); } while (0)
#define PG8_STAGE2(bufoff, gbase, o0, o1) do { \
        __builtin_amdgcn_global_load_lds((const unsigned*)((const char*)(gbase) + (o0)), (LAS unsigned*)(lds + (bufoff) + ldsw), 16, 0, 0); \
        __builtin_amdgcn_global_load_lds((const unsigned*)((const char*)(gbase) + (o1)), (LAS unsigned*)(lds + (bufoff) + ldsw + 8192), 16, 0, 0); } while (0)
#define PG8_LDA(dst, b, h) do { _Pragma("unroll") for (int m = 0; m < 4; ++m) _Pragma("unroll") for (int k = 0; k < 2; ++k) dst[m][k] = *(const LAS bf16x8*)(lds + PG8_SA(b, h) + aoffk[k] + m * 2048); } while (0)
#define PG8_LDB(dst, b, h) do { _Pragma("unroll") for (int n = 0; n < 2; ++n) _Pragma("unroll") for (int k = 0; k < 2; ++k) dst[n][k] = *(const LAS bf16x8*)(lds + PG8_SB(b, h) + boff + n * 2048 + k * 1024); } while (0)
#define PG8_MMA(ai, bj, At, Bt) do { __builtin_amdgcn_s_setprio(1); _Pragma("unroll") for (int m = 0; m < 4; ++m) _Pragma("unroll") for (int n = 0; n < 2; ++n) _Pragma("unroll") for (int k = 0; k < 2; ++k) \
        acc[ai][bj][m][n] = __builtin_amdgcn_mfma_f32_16x16x32_bf16(Bt[n][k], At[m][k], acc[ai][bj][m][n], 0, 0, 0); __builtin_amdgcn_s_setprio(0); } while (0)
#define PG8_WAIT_V(n) asm volatile("s_waitcnt vmcnt(" #n ")" ::: "memory")
#define PG8_WAIT_L(n) asm volatile("s_waitcnt lgkmcnt(" #n ")" ::: "memory")
#define PG8_BAR __builtin_amdgcn_s_barrier()
#define PG8_SCHED __builtin_amdgcn_sched_barrier(0)
#define PG8_STA(bufoff, kt, h, NXT) do { if constexpr (GATHER) { const char* _b = (const char*)g.A + (size_t)(kt) * kstep; \
            if ((h) == 0) PG8_STAGE2(bufoff, _b, gc00, gc01); else PG8_STAGE2(bufoff, _b, gc10, gc11); } \
        else { const char* _b = ((NXT) ? nA : cA) + (size_t)(kt) * kstepA + (size_t)(h) * hstep; PG8_STAGE(bufoff, _b, voffA); } } while (0)
    Unit cur, nxt; int ui = 0;
    if (!S.next(0, cur)) return;
    f32x4 acc[2][2][4][2];
#pragma unroll
    for (int a = 0; a < 2; ++a)
#pragma unroll
        for (int b = 0; b < 2; ++b)
#pragma unroll
            for (int m = 0; m < 4; ++m)
#pragma unroll
                for (int n = 0; n < 2; ++n) acc[a][b][m][n] = (f32x4){0.f, 0.f, 0.f, 0.f};
    bf16x8 At[4][2], B0[2][2], B1[2][2];
    const char* cA = (const char*)g.A + (size_t)cur.pm * tstep; const char* cB = PG8_BBASE(cur.pn);
    const char* nA = cA;
    unsigned gc00 = 0, gc01 = 0, gc10 = 0, gc11 = 0;
    if constexpr (GATHER) { PG8_GOFF(cur.pm, gc00, gc01, gc10, gc11); }
    PG8_STAGE(PG8_SB(0, 0), cB, voffB); PG8_STAGE(PG8_SB(0, 1), cB + hstepB, voffB); PG8_STA(PG8_SA(0, 0), 0, 0, false); PG8_STA(PG8_SA(0, 1), 0, 1, false);
    if (wr == 1) PG8_BAR;
    PG8_WAIT_V(2); PG8_BAR;
    PG8_STAGE(PG8_SB(1, 0), cB + kstepB, voffB); PG8_STA(PG8_SA(1, 0), 1, 0, false); PG8_STAGE(PG8_SB(1, 1), cB + hstepB + kstepB, voffB);
    PG8_WAIT_V(6); PG8_BAR;
    for (;;) {
        const bool has_next = S.next(ui + 1, nxt);
        nA = has_next ? (const char*)g.A + (size_t)nxt.pm * tstep : cA; const char* nB = has_next ? PG8_BBASE(nxt.pn) : cB;
        if constexpr (GATHER) { if (has_next && wid == 0) __builtin_amdgcn_global_load_lds((const unsigned*)(g.gidx + nxt.pm * BM) + lane * 4, (LAS unsigned*)(lds + STAGE_BYTES), 16, 0, 0); }
        if constexpr (Epi::ROWSCALE) { if (wid == 0) __builtin_amdgcn_global_load_lds((const unsigned*)(E.gate + cur.pm * BM) + lane * 4, (LAS unsigned*)(lds + STAGE_BYTES + (ui & 1) * 1024), 16, 0, 0); }
        for (int t = 0; t < nt; t += 2) {
            const bool last = (t == nt - 2);

            const int k2 = last ? 0 : t + 2, k3 = k2 + 1;
            const char* b2 = last ? nB : cB + (size_t)(t + 2) * kstepB; const char* b3 = b2 + kstepB;
            PG8_LDB(B0, 0, 0); PG8_LDB(B1, 0, 1); PG8_SCHED; PG8_LDA(At, 0, 0); PG8_STA(PG8_SA(1, 1), t + 1, 1, false);
            PG8_WAIT_V(8); PG8_WAIT_L(0); PG8_BAR; PG8_MMA(0, 0, At, B0); PG8_MMA(0, 1, At, B1); PG8_BAR; PG8_SCHED;
            if constexpr (GATHER) { if (last && has_next) { const LAS int* _li = (const LAS int*)(lds + STAGE_BYTES); int _R0, _C0, _R1, _C1; a_stage_rc(tid, 0, _R0, _C0); a_stage_rc(tid, 1, _R1, _C1);
                gc00 = ((unsigned)_li[_R0] * (unsigned)K + (unsigned)_C0) * 2u; gc01 = ((unsigned)_li[_R1] * (unsigned)K + (unsigned)_C1) * 2u;
                gc10 = ((unsigned)_li[HALF + _R0] * (unsigned)K + (unsigned)_C0) * 2u; gc11 = ((unsigned)_li[HALF + _R1] * (unsigned)K + (unsigned)_C1) * 2u; } }
            PG8_LDA(At, 0, 1); PG8_STAGE(PG8_SB(0, 0), b2, voffB); PG8_STAGE(PG8_SB(0, 1), b2 + hstepB, voffB); if (last) PG8_STA(PG8_SA(0, 0), k2, 0, true); else PG8_STA(PG8_SA(0, 0), k2, 0, false);
            PG8_WAIT_V(8); PG8_WAIT_L(0); PG8_BAR; PG8_MMA(1, 0, At, B0); PG8_MMA(1, 1, At, B1); PG8_BAR; PG8_SCHED;
            PG8_LDB(B0, 1, 0); PG8_LDB(B1, 1, 1); PG8_SCHED; PG8_LDA(At, 1, 0); if (last) PG8_STA(PG8_SA(0, 1), k2, 1, true); else PG8_STA(PG8_SA(0, 1), k2, 1, false);
            PG8_WAIT_V(8); PG8_WAIT_L(0); PG8_BAR; PG8_MMA(0, 0, At, B0); PG8_MMA(0, 1, At, B1); PG8_BAR; PG8_SCHED;
            PG8_LDA(At, 1, 1); PG8_STAGE(PG8_SB(1, 0), b3, voffB); PG8_STAGE(PG8_SB(1, 1), b3 + hstepB, voffB); if (last) PG8_STA(PG8_SA(1, 0), k3, 0, true); else PG8_STA(PG8_SA(1, 0), k3, 0, false);
            PG8_WAIT_V(8); PG8_WAIT_L(0); PG8_BAR; PG8_MMA(1, 0, At, B0); PG8_MMA(1, 1, At, B1); PG8_BAR; PG8_SCHED;
        }
        if (wr == 0) PG8_BAR;
        if constexpr (Epi::ROWSCALE) E(acc, cur, wr, wc, fr, fq, (const LAS float*)(lds + STAGE_BYTES + (ui & 1) * 1024)); else E(acc, cur, wr, wc, fr, fq);
        if (!has_next) break;
#pragma unroll
        for (int a = 0; a < 2; ++a)
#pragma unroll
            for (int b = 0; b < 2; ++b)
#pragma unroll
                for (int m = 0; m < 4; ++m)
#pragma unroll
                    for (int n = 0; n < 2; ++n) acc[a][b][m][n] = (f32x4){0.f, 0.f, 0.f, 0.f};
        cur = nxt; cA = nA; cB = nB; ++ui;
        if (wr == 1) PG8_BAR;
    }
    PG8_WAIT_V(0);
    PG8_BAR;
#undef PG8_BBASE
#undef PG8_SA
#undef PG8_SB
#undef PG8_STAGE
#undef PG8_STAGE2
#undef PG8_STA
#undef PG8_GOFF
#undef PG8_LDA
#undef PG8_LDB
#undef PG8_MMA
#undef PG8_WAIT_V
#undef PG8_WAIT_L
#undef PG8_BAR
#undef PG8_SCHED
}
}

#define XB_TMO      128
#define XB_XCNT(j)  (256  + 64 * (j))
#define XB_XSUB(j)  (1280 + 64 * (j))
#define XB_XGEN(j)  (2304 + 64 * (j))
#define XB_TOP      3328
#define XB_TOPGEN   3392
#define XCD_BAR_WORDS 3456
#define XB_SPIN_CAP (1u << 22)
__device__ __forceinline__ unsigned xb_ld(unsigned* p)              { return __hip_atomic_load(p, __ATOMIC_RELAXED, __HIP_MEMORY_SCOPE_AGENT); }
__device__ __forceinline__ unsigned xb_add(unsigned* p, unsigned v) { return __hip_atomic_fetch_add(p, v, __ATOMIC_RELAXED, __HIP_MEMORY_SCOPE_AGENT); }
__device__ __forceinline__ unsigned xb_xcc_id() { return (unsigned)__builtin_amdgcn_s_getreg((3 << 11) | 20) & 0xFu; }
#define XB_SPIN(cond, bar) do { unsigned _sp = 0; while (cond) { __builtin_amdgcn_s_sleep(1); \
    if ((++_sp & 255u) == 0u) { if (xb_ld(&(bar)[XB_TMO])) break; if (_sp > XB_SPIN_CAP) { atomicAdd(&(bar)[XB_TMO], 1u); break; } } } } while (0)
struct XcdBarrier { unsigned* bar; unsigned x; volatile LAS unsigned* st; };
__device__ __forceinline__ XcdBarrier xcd_barrier_post(unsigned* bar, volatile LAS unsigned* st) {
    XcdBarrier b; b.bar = bar; b.x = xb_xcc_id(); b.st = st;
    if (threadIdx.x == 0) (void)xb_add(&bar[XB_XCNT(b.x)], 1u);
    return b;
}
__device__ __forceinline__ void xcd_barrier_complete(unsigned* bar, unsigned x, unsigned& nloc, unsigned& nx) {
    const unsigned G = gridDim.x * gridDim.y * gridDim.z;
    unsigned sum, cnt, mine, sp = 0u;
    for (;;) {
        sum = 0u; cnt = 0u; mine = 0u;
#pragma unroll
        for (unsigned j = 0; j < 16; ++j) { const unsigned c = xb_ld(&bar[XB_XCNT(j)]); sum += c; cnt += (c > 0u) ? 1u : 0u; mine = (j == x) ? c : mine; }
        if (sum == G) break;
        __builtin_amdgcn_s_sleep(1);
        if ((++sp & 255u) == 0u) { if (xb_ld(&bar[XB_TMO])) break; if (sp > XB_SPIN_CAP) { atomicAdd(&bar[XB_TMO], 1u); break; } }
    }
    nloc = mine > 0u ? mine : 1u; nx = cnt > 0u ? cnt : 1u;
}
__device__ __forceinline__ void xcd_barrier(const XcdBarrier& b) {
    asm volatile("s_waitcnt vmcnt(0)" ::: "memory");
    __syncthreads();
    if (threadIdx.x == 0) {
        unsigned* bar = b.bar;
        __builtin_amdgcn_s_waitcnt(0);
        unsigned nloc = b.st[0], nx = b.st[1];
        if (nloc == 0u) { xcd_barrier_complete(bar, b.x, nloc, nx); b.st[0] = nloc; b.st[1] = nx; }
        const unsigned old = xb_add(&bar[XB_XSUB(b.x)], 1u);
        const unsigned gen = old / nloc;
        if (old + 1u == (gen + 1u) * nloc) {
            __builtin_amdgcn_fence(__ATOMIC_RELEASE, "agent");
            asm volatile("s_waitcnt vmcnt(0)" ::: "memory");
            const unsigned og = xb_add(&bar[XB_TOP], 1u);
            const unsigned tg = og / nx;
            if (og + 1u == (tg + 1u) * nx) xb_add(&bar[XB_TOPGEN], 1u);
            else XB_SPIN(xb_ld(&bar[XB_TOPGEN]) == tg, bar);
            __builtin_amdgcn_fence(__ATOMIC_ACQUIRE, "agent");
            xb_add(&bar[XB_XGEN(b.x)], 1u);
            asm volatile("s_waitcnt vmcnt(0)" ::: "memory");
        } else {
            XB_SPIN(xb_ld(&bar[XB_XGEN(b.x)]) == gen, bar);
            __builtin_amdgcn_fence(__ATOMIC_ACQUIRE, "agent");
            asm volatile("s_waitcnt vmcnt(0)" ::: "memory");
        }
    }
    __syncthreads();
}

#define LDS_WAIT() asm volatile("s_waitcnt lgkmcnt(0)" ::: "memory")
#define VM_WAIT() asm volatile("s_waitcnt vmcnt(0)" ::: "memory")
#define SBAR() __builtin_amdgcn_sched_barrier(0)
__device__ __forceinline__ float uni_f(float v) { return __builtin_bit_cast(float, __builtin_amdgcn_readfirstlane(__builtin_bit_cast(int, v))); }
__device__ __forceinline__ int crow(int r, int hi) { return (r & 3) + 8 * (r >> 2) + 4 * hi; }
__device__ __forceinline__ void glds16(const void* gsrc, unsigned lds_dst) { unsigned keep;
    asm volatile("s_mov_b32 %0, m0\n\ts_mov_b32 m0, %2\n\ts_nop 0\n\tglobal_load_lds_dwordx4 %1, off\n\ts_mov_b32 m0, %0" : "=&s"(keep) : "v"(gsrc), "s"(lds_dst) : "memory"); }
typedef LAS const char* lds_cptr;
typedef short v4i16_t __attribute__((ext_vector_type(4)));
__device__ __forceinline__ s16x4 vtr(lds_cptr p) { return __builtin_bit_cast(s16x4, __builtin_amdgcn_ds_read_tr16_b64_v4i16((LAS v4i16_t*)p)); }
__device__ __forceinline__ float pl32_max(float m) { auto rr = __builtin_amdgcn_permlane32_swap(__float_as_uint(m), __float_as_uint(m), false, false); return fmaxf(__uint_as_float(rr[0]), __uint_as_float(rr[1])); }
__device__ __forceinline__ float pl32_sum(float m) { auto rr = __builtin_amdgcn_permlane32_swap(__float_as_uint(m), __float_as_uint(m), false, false); return __uint_as_float(rr[0]) + __uint_as_float(rr[1]); }

#define LDS_RD128(dst, addr, off) asm volatile("ds_read_b128 %0, %1 offset:%c2" : "=&v"(dst) : "v"(addr), "i"(off) : "memory")
#define LDS_TR64(dst, addr, off) asm volatile("ds_read_b64_tr_b16 %0, %1 offset:%c2" : "=&v"(dst) : "v"(addr), "i"(off) : "memory")
__device__ __forceinline__ const char* uni_ptr(const void* p) { const unsigned long long u = (unsigned long long)p;
    const unsigned lo = (unsigned)__builtin_amdgcn_readfirstlane((int)(unsigned)u), hi = (unsigned)__builtin_amdgcn_readfirstlane((int)(unsigned)(u >> 32)); return (const char*)(((unsigned long long)hi << 32) | lo); }
__device__ __forceinline__ void glds16s(const void* sbase, unsigned voff, unsigned lds_dst) { unsigned keep;
    asm volatile("s_mov_b32 %0, m0\n\ts_mov_b32 m0, %3\n\ts_nop 0\n\tglobal_load_lds_dwordx4 %1, %2\n\ts_mov_b32 m0, %0" : "=&s"(keep) : "v"(voff), "s"(sbase), "s"(lds_dst) : "memory"); }
__device__ __forceinline__ void qkt_asm(f32x16& p0, f32x16& p1, unsigned ka, const bf16x8* qr, const f32x16& cinit) {
    bf16x8 k0, k1, k2, k3, k4, k5, k6, k7;
    asm volatile("s_waitcnt lgkmcnt(0)" ::: "memory");
    LDS_RD128(k0, ka, 0); LDS_RD128(k1, ka, 512); LDS_RD128(k2, ka, 2048); LDS_RD128(k3, ka, 2560);
    asm volatile("s_waitcnt lgkmcnt(2)" : "+v"(k0), "+v"(k1));
    p0 = __builtin_amdgcn_mfma_f32_32x32x16_bf16(k0, qr[0], cinit, 0, 0, 0); p1 = __builtin_amdgcn_mfma_f32_32x32x16_bf16(k1, qr[0], cinit, 0, 0, 0);
    asm volatile("" : "+v"(p0), "+v"(p1));
    LDS_RD128(k4, ka, 4096); LDS_RD128(k5, ka, 4608);
    asm volatile("s_waitcnt lgkmcnt(2)" : "+v"(k2), "+v"(k3));
    p0 = __builtin_amdgcn_mfma_f32_32x32x16_bf16(k2, qr[1], p0, 0, 0, 0); p1 = __builtin_amdgcn_mfma_f32_32x32x16_bf16(k3, qr[1], p1, 0, 0, 0);
    asm volatile("" : "+v"(p0), "+v"(p1));
    LDS_RD128(k6, ka, 6144); LDS_RD128(k7, ka, 6656);
    asm volatile("s_waitcnt lgkmcnt(2)" : "+v"(k4), "+v"(k5));
    p0 = __builtin_amdgcn_mfma_f32_32x32x16_bf16(k4, qr[2], p0, 0, 0, 0); p1 = __builtin_amdgcn_mfma_f32_32x32x16_bf16(k5, qr[2], p1, 0, 0, 0);
    asm volatile("s_waitcnt lgkmcnt(0)" : "+v"(k6), "+v"(k7));
    p0 = __builtin_amdgcn_mfma_f32_32x32x16_bf16(k6, qr[3], p0, 0, 0, 0); p1 = __builtin_amdgcn_mfma_f32_32x32x16_bf16(k7, qr[3], p1, 0, 0, 0);
}
__device__ __forceinline__ void qkt_na(f32x16& p0, f32x16& p1, const unsigned (&ka)[4], const bf16x8* qr, const f32x16& cinit) {
    bf16x8 k0, k1, k2, k3, k4, k5, k6, k7;
    asm volatile("s_waitcnt lgkmcnt(0)" ::: "memory");
    LDS_RD128(k0, ka[0], 0); LDS_RD128(k1, ka[0], 4096); LDS_RD128(k2, ka[1], 0); LDS_RD128(k3, ka[1], 4096);
    asm volatile("s_waitcnt lgkmcnt(2)" : "+v"(k0), "+v"(k1));
    p0 = __builtin_amdgcn_mfma_f32_32x32x16_bf16(k0, qr[0], cinit, 0, 0, 0); p1 = __builtin_amdgcn_mfma_f32_32x32x16_bf16(k1, qr[0], cinit, 0, 0, 0);
    asm volatile("" : "+v"(p0), "+v"(p1));
    LDS_RD128(k4, ka[2], 0); LDS_RD128(k5, ka[2], 4096);
    asm volatile("s_waitcnt lgkmcnt(2)" : "+v"(k2), "+v"(k3));
    p0 = __builtin_amdgcn_mfma_f32_32x32x16_bf16(k2, qr[1], p0, 0, 0, 0); p1 = __builtin_amdgcn_mfma_f32_32x32x16_bf16(k3, qr[1], p1, 0, 0, 0);
    asm volatile("" : "+v"(p0), "+v"(p1));
    LDS_RD128(k6, ka[3], 0); LDS_RD128(k7, ka[3], 4096);
    asm volatile("s_waitcnt lgkmcnt(2)" : "+v"(k4), "+v"(k5));
    p0 = __builtin_amdgcn_mfma_f32_32x32x16_bf16(k4, qr[2], p0, 0, 0, 0); p1 = __builtin_amdgcn_mfma_f32_32x32x16_bf16(k5, qr[2], p1, 0, 0, 0);
    asm volatile("s_waitcnt lgkmcnt(0)" : "+v"(k6), "+v"(k7));
    p0 = __builtin_amdgcn_mfma_f32_32x32x16_bf16(k6, qr[3], p0, 0, 0, 0); p1 = __builtin_amdgcn_mfma_f32_32x32x16_bf16(k7, qr[3], p1, 0, 0, 0);
}
#define PV_RD(L, H, D0) do { LDS_TR64(L##0, va, (D0) * 4096); LDS_TR64(H##0, va, (D0) * 4096 + 512); LDS_TR64(L##1, va, (D0) * 4096 + 1024); LDS_TR64(H##1, va, (D0) * 4096 + 1536); \
        LDS_TR64(L##2, va, (D0) * 4096 + 2048); LDS_TR64(H##2, va, (D0) * 4096 + 2560); LDS_TR64(L##3, va, (D0) * 4096 + 3072); LDS_TR64(H##3, va, (D0) * 4096 + 3584); } while (0)
#define PV_PK(L, H) (bf16x8){L[0], L[1], L[2], L[3], H[0], H[1], H[2], H[3]}
#define PV_MM(L, H, D0) do { o[D0] = __builtin_amdgcn_mfma_f32_32x32x16_bf16(a0, PV_PK(L##0, H##0), o[D0], 0, 0, 0); o[D0] = __builtin_amdgcn_mfma_f32_32x32x16_bf16(a1, PV_PK(L##1, H##1), o[D0], 0, 0, 0); \
        o[D0] = __builtin_amdgcn_mfma_f32_32x32x16_bf16(a2, PV_PK(L##2, H##2), o[D0], 0, 0, 0); o[D0] = __builtin_amdgcn_mfma_f32_32x32x16_bf16(a3, PV_PK(L##3, H##3), o[D0], 0, 0, 0); } while (0)
#define PV_WAIT(N, L, H) asm volatile("s_waitcnt lgkmcnt(" #N ")" : "+v"(L##0), "+v"(H##0), "+v"(L##1), "+v"(H##1), "+v"(L##2), "+v"(H##2), "+v"(L##3), "+v"(H##3))
template <int NQ> __device__ __forceinline__ void pv_asm(f32x16* o, unsigned va, bf16x8 a0, bf16x8 a1, bf16x8 a2, bf16x8 a3) {
    s16x4 xl0, xl1, xl2, xl3, xh0, xh1, xh2, xh3, yl0, yl1, yl2, yl3, yh0, yh1, yh2, yh3;
    asm volatile("s_waitcnt lgkmcnt(0)" ::: "memory");
    PV_RD(xl, xh, 0);
    if (NQ == 2) { PV_RD(yl, yh, 1); PV_WAIT(8, xl, xh); PV_MM(xl, xh, 0); PV_WAIT(0, yl, yh); PV_MM(yl, yh, 1); }
    else { PV_RD(yl, yh, 1); PV_WAIT(8, xl, xh); PV_MM(xl, xh, 0); PV_RD(xl, xh, 2); PV_WAIT(8, yl, yh); PV_MM(yl, yh, 1); PV_RD(yl, yh, 3); PV_WAIT(8, xl, xh); PV_MM(xl, xh, 2); PV_WAIT(0, yl, yh); PV_MM(yl, yh, 3); }
}

struct ImItem { const char* src; char* dst; unsigned ldw4; };
#define IM_LOAD(V, I, lo4) do { _Pragma("unroll") for (int k_ = 0; k_ < 32; ++k_) V[k_] = *(const float*)((I).src + (size_t)((unsigned)k_ * (I).ldw4 + (lo4))); } while (0)
#define IM_STORE(V, I, scr, wofs, swz, lane16) do { _Pragma("unroll") for (int c_ = 0; c_ < 4; ++c_) { u32x4 o_; o_.x = cvt_pk_bf16(V[c_ * 8 + 0], V[c_ * 8 + 1]); o_.y = cvt_pk_bf16(V[c_ * 8 + 2], V[c_ * 8 + 3]); \
            o_.z = cvt_pk_bf16(V[c_ * 8 + 4], V[c_ * 8 + 5]); o_.w = cvt_pk_bf16(V[c_ * 8 + 6], V[c_ * 8 + 7]); *(LAS u32x4*)((scr) + (wofs) + (((unsigned)c_ * 16u) ^ (swz))) = o_; } \
        _Pragma("unroll") for (int s_ = 0; s_ < 4; ++s_) { const u32x4 o_ = *(const LAS u32x4*)((scr) + s_ * 1024 + (lane16)); *(u32x4*)((I).dst + (size_t)((unsigned)s_ * 2048u + (lane16))) = o_; } } while (0)
#define IM_LOAD_NT(V, I, lo4) do { _Pragma("unroll") for (int k_ = 0; k_ < 32; ++k_) V[k_] = __builtin_nontemporal_load((const float*)((I).src + (size_t)((unsigned)k_ * (I).ldw4 + (lo4)))); } while (0)
#define IM_STORE_NT(V, I, scr, wofs, swz, lane16) do { _Pragma("unroll") for (int c_ = 0; c_ < 4; ++c_) { u32x4 o_; o_.x = cvt_pk_bf16(V[c_ * 8 + 0], V[c_ * 8 + 1]); o_.y = cvt_pk_bf16(V[c_ * 8 + 2], V[c_ * 8 + 3]); \
            o_.z = cvt_pk_bf16(V[c_ * 8 + 4], V[c_ * 8 + 5]); o_.w = cvt_pk_bf16(V[c_ * 8 + 6], V[c_ * 8 + 7]); *(LAS u32x4*)((scr) + (wofs) + (((unsigned)c_ * 16u) ^ (swz))) = o_; } \
        _Pragma("unroll") for (int s_ = 0; s_ < 4; ++s_) { const u32x4 o_ = *(const LAS u32x4*)((scr) + s_ * 1024 + (lane16)); __builtin_nontemporal_store(o_, (u32x4*)((I).dst + (size_t)((unsigned)s_ * 2048u + (lane16)))); } } while (0)
__device__ __forceinline__ void im_lane(int lane, unsigned& wofs, unsigned& swz) {
    const unsigned pos = (unsigned)((lane & 32) | (((lane >> 2) & 1) << 4) | (((lane >> 3) & 3) << 2) | (lane & 3)); wofs = (pos >> 4) * 1024u + (pos & 15u) * 64u; swz = (pos & 8u) << 2; }
__device__ __forceinline__ ImItem im_dense_item(const float* W, int N, int K, bf16_t* WT, int kh, int nb) {
    ImItem I; I.src = (const char*)(W + (size_t)(32 * kh) * N + 64 * nb); I.ldw4 = (unsigned)N * 4u;
    I.dst = (char*)WT + ((size_t)(nb >> 1) * (K / 64) + (kh >> 1)) * 16384 + (size_t)(((nb & 1) * 4) * 2 + (kh & 1)) * 1024; return I; }

struct Args { const float* in[20]; float* out; unsigned char* ws; int ph_lo, ph_hi; };
static_assert(sizeof(Args) == 22 * 8 + 8, "no padding");
typedef const __attribute__((address_space(4))) Args* KArgs;
enum { I_X = 0, I_WINAB, I_RPB, I_LAMQK, I_SUBLN, I_WOUTAB, I_WINC, I_LNVG, I_LNVB, I_WS, I_BS, I_WOUTC, I_LNMG, I_LNMB, I_WR, I_WG, I_WU, I_WDN, I_LNFG, I_LNFB };

__device__ __forceinline__ void phase_prologue(KArgs a, LAS unsigned char* lds, int gw, int NGW, int wave, int lane) {
    unsigned char* ws = a->ws;
    constexpr int I_AB = 32 * 48, I_OAB = 32 * 16, I_C = 32 * 32, I_OC = 32 * 16, I_ALL = 2 * (I_AB + I_OAB + I_C + I_OC);
    LAS unsigned char* scr = lds + 4096 + wave * 4096;
    const unsigned lo4 = 4u * (unsigned)lane, lane16 = 16u * (unsigned)lane; unsigned wofs, swz; im_lane(lane, wofs, swz);
    auto dense_item = [&](int it) -> ImItem {
        int r = it; const int i = r & 1; r >>= 1;
        if (r < I_AB) return im_dense_item(a->in[I_WINAB] + (size_t)i * D * QKVW, QKVW, D, (bf16_t*)(ws + WS_WINAB) + (size_t)i * QKVW * D, r / 48, r % 48);
        if ((r -= I_AB) < I_OAB) return im_dense_item(a->in[I_WOUTAB] + (size_t)i * D * D, D, D, (bf16_t*)(ws + WS_WOUTAB) + (size_t)i * D * D, r / 16, r % 16);
        if ((r -= I_OAB) < I_C) return im_dense_item(a->in[I_WINC] + (size_t)i * D * 2048, 2048, D, (bf16_t*)(ws + WS_WINC) + (size_t)i * 2048 * D, r / 32, r % 32);
        r -= I_C; return im_dense_item(a->in[I_WOUTC] + (size_t)i * D * D, D, D, (bf16_t*)(ws + WS_WOUTC) + (size_t)i * D * D, r / 16, r % 16); };
    for (int it = gw; it < I_ALL; it += 2 * NGW) {
        const bool two = it + NGW < I_ALL;
        const ImItem I0 = dense_item(it), I1 = dense_item(two ? it + NGW : it);
        float v0[32], v1[32]; IM_LOAD(v0, I0, lo4); IM_LOAD(v1, I1, lo4);
        asm volatile("" ::: "memory");
        IM_STORE(v0, I0, scr, wofs, swz, lane16);
        if (two) IM_STORE(v1, I1, scr, wofs, swz, lane16);
    }
    { const float* src = a->in[I_WS]; bf16_t* dst = (bf16_t*)(ws + WS_WSB);
      for (int i = gw * 64 + lane; i < 262144 / 8; i += NGW * 64) { const f32x4 v0 = *(const f32x4*)(src + (size_t)i * 8), v1 = *(const f32x4*)(src + (size_t)i * 8 + 4);
          u32x4 o; o.x = cvt_pk_bf16(v0[0], v0[1]); o.y = cvt_pk_bf16(v0[2], v0[3]); o.z = cvt_pk_bf16(v1[0], v1[1]); o.w = cvt_pk_bf16(v1[2], v1[3]); *(u32x4*)(dst + (size_t)i * 8) = o; } }
    { const float* x = a->in[I_X]; bf16_t* xb = (bf16_t*)(ws + WS_XB);
      for (int m = gw; m < T; m += 4 * NGW) { f32x4 v[4][4];
#pragma unroll
          for (int r = 0; r < 4; ++r) { const int mr = (m + r * NGW < T) ? m + r * NGW : m; const f32x4* xr = (const f32x4*)(x + (size_t)mr * D) + lane;
#pragma unroll
              for (int j = 0; j < 4; ++j) v[r][j] = xr[64 * j]; }
          asm volatile("" ::: "memory");
#pragma unroll
          for (int r = 0; r < 4; ++r) { if (m + r * NGW < T) { u32x2* o = (u32x2*)(xb + (size_t)(m + r * NGW) * D) + lane;
#pragma unroll
              for (int j = 0; j < 4; ++j) { u32x2 w; w.x = cvt_pk_bf16(v[r][j][0], v[r][j][1]); w.y = cvt_pk_bf16(v[r][j][2], v[r][j][3]); o[64 * j] = w; } } } } }
}

__device__ __forceinline__ ImItem moe_item(const float* wg, const float* wu, const float* wd, unsigned char* ws, unsigned it) {
    const unsigned e = it / 3072u; unsigned r = it % 3072u; const unsigned which = r >> 10; r &= 1023u; ImItem I;
    if (which < 2) { const unsigned kh = r >> 5, nb = r & 31u; I.src = (const char*)((which ? wu : wg) + (size_t)e * D * DEXP + (size_t)(32 * kh) * DEXP + 64 * nb); I.ldw4 = DEXP * 4;
        I.dst = (char*)ws + WS_WGU + ((size_t)(e * 32 + (nb >> 1) * 2 + which) * 16 + (kh >> 1)) * 16384 + (size_t)(((nb & 1) * 4) * 2 + (kh & 1)) * 1024; }
    else { const unsigned kh = r >> 4, nb = r & 15u; I.src = (const char*)(wd + (size_t)e * DEXP * D + (size_t)(32 * kh) * D + 64 * nb); I.ldw4 = D * 4;
        I.dst = (char*)ws + WS_WD + ((size_t)(e * 8 + (nb >> 1)) * 32 + (kh >> 1)) * 16384 + (size_t)(((nb & 1) * 4) * 2 + (kh & 1)) * 1024; }
    return I;
}
__device__ __forceinline__ void phase_moe_convert(KArgs a, int l, LAS unsigned char* lds, int gw, int NGW, int wave, int lane, int qsel = 0) {
    unsigned char* ws = a->ws + (size_t)(l & 1) * WS_WDELTA;
    const float* wg = a->in[I_WG] + (size_t)l * NE * D * DEXP; const float* wu = a->in[I_WU] + (size_t)l * NE * D * DEXP; const float* wd = a->in[I_WDN] + (size_t)l * NE * DEXP * D;
    constexpr unsigned TOT = NE * 3 * 1024;
    unsigned* qhead = (unsigned*)(a->ws + WS_CTL) + 1024 + 64 * l + 32 * qsel;
    LAS unsigned char* scr = lds + 4096 + wave * 4096;
    const unsigned lo4 = 4u * (unsigned)lane, lane16 = 16u * (unsigned)lane; unsigned wofs, swz; im_lane(lane, wofs, swz);
#define MC_TICKET() __builtin_amdgcn_atomic_inc32(qhead, 0xffffffffu, __ATOMIC_RELAXED, "agent")
    unsigned tkv = 0; if (lane == 0) tkv = MC_TICKET();
    unsigned cur = 16u * (unsigned)__builtin_amdgcn_readfirstlane((int)tkv), left = 16;
    if (cur >= TOT) return;
    tkv = 0; if (lane == 0) tkv = MC_TICKET();
#define MC_NEXT(id) do { if (left == 0) { unsigned z_; asm volatile("v_mov_b32 %0, 0" : "=v"(z_)); cur = 16u * (unsigned)__builtin_amdgcn_readfirstlane((int)(tkv + z_)); left = 16; tkv = TOT / 16; \
            if (cur < TOT && lane == 0) tkv = MC_TICKET(); } \
        id = cur; if (cur < TOT) { ++cur; --left; } } while (0)
    float va[32], vb[32];
    unsigned ida, idb; ImItem Ia, Ib;
    MC_NEXT(ida); Ia = moe_item(wg, wu, wd, ws, ida); IM_LOAD_NT(va, Ia, lo4);
    MC_NEXT(idb); Ib = moe_item(wg, wu, wd, ws, idb < TOT ? idb : TOT - 1); IM_LOAD_NT(vb, Ib, lo4);
    asm volatile("" ::: "memory");
    do {
        IM_STORE_NT(va, Ia, scr, wofs, swz, lane16);
        asm volatile("" ::: "memory");
        MC_NEXT(ida); Ia = moe_item(wg, wu, wd, ws, ida < TOT ? ida : TOT - 1); IM_LOAD_NT(va, Ia, lo4);
        asm volatile("" ::: "memory");
        IM_STORE_NT(vb, Ib, scr, wofs, swz, lane16);
        asm volatile("" ::: "memory");
        MC_NEXT(idb); Ib = moe_item(wg, wu, wd, ws, idb < TOT ? idb : TOT - 1); IM_LOAD_NT(vb, Ib, lo4);
        asm volatile("" ::: "memory");
    } while (ida < TOT);
#undef MC_NEXT
#undef MC_TICKET
}

constexpr int RT_PITCH = 2064;
constexpr int RT_WLO = 16 * RT_PITCH, RT_XT = 2 * 16 * RT_PITCH;
template <bool L0> __device__ __forceinline__ void phase_ln_router(KArgs a, int l, LAS unsigned char* lds, int gw, int NGW, int tid, int lane) {
    unsigned char* ws = a->ws;
    const float* xres = a->in[I_X];
    const bf16_t* hm = (const bf16_t*)(ws + WS_HM);
    bf16_t* xb = (bf16_t*)(ws + WS_XB);
    float* afft = (float*)(ws + WS_AFFT); int* inv = (int*)(ws + WS_INV);
    const float* lg = a->in[I_LNMG] + (size_t)l * D; const float* lb = a->in[I_LNMB] + (size_t)l * D; const float* wr = a->in[I_WR] + (size_t)l * D * NE;
    const int wid = tid >> 6;
    { float wv[32];
#pragma unroll
      for (int u = 0; u < 32; ++u) wv[u] = wr[tid + u * (NWAVES * 64)];
#pragma unroll
      for (int u = 0; u < 32; ++u) { const int i = tid + u * (NWAVES * 64); const int k = i >> 4, e = i & 15; const float w = wv[u];
        const unsigned hi = cvt_pk_bf16(w, 0.f) & 0xffffu; const float rem = w - __uint_as_float(hi << 16);
        *(LAS bf16_t*)(lds + e * RT_PITCH + k * 2) = (bf16_t)hi; *(LAS bf16_t*)(lds + RT_WLO + e * RT_PITCH + k * 2) = (bf16_t)(cvt_pk_bf16(rem, 0.f) & 0xffffu); } }
    __syncthreads();
    f32x4 gv[4], bv[4];
#pragma unroll
    for (int j = 0; j < 4; ++j) { gv[j] = *((const f32x4*)lg + lane + 64 * j); bv[j] = *((const f32x4*)lb + lane + 64 * j); }
    LAS unsigned char* xt = lds + RT_XT + wid * (4 * RT_PITCH);
    const unsigned lds0 = (unsigned)(uintptr_t)lds;
    const unsigned xa = lds0 + RT_XT + wid * (4 * RT_PITCH) + (lane & 3) * RT_PITCH + (lane >> 4) * 16;
    const unsigned wa = lds0 + (lane & 15) * RT_PITCH + (lane >> 4) * 16;
    u32x4 xs0[4], xs1[4], xs2[4], xs3[4]; u32x2 hs0[4], hs1[4], hs2[4], hs3[4];
#define LR_LOAD(X, H, M) do { const int m_ = (M) < T ? (M) : T - 1; \
        if (L0) { _Pragma("unroll") for (int j = 0; j < 4; ++j) X[j] = *((const u32x4*)(xres + (size_t)m_ * D) + lane + 64 * j); } \
        else { _Pragma("unroll") for (int j = 0; j < 4; ++j) { const u32x2 r_ = *((const u32x2*)(xb + (size_t)m_ * D) + lane + 64 * j); X[j].x = r_.x; X[j].y = r_.y; } } \
        _Pragma("unroll") for (int j = 0; j < 4; ++j) H[j] = *((const u32x2*)(hm + (size_t)m_ * D) + lane + 64 * j); } while (0)
#define LR_ROW(X, H, RJ, M) do { const int m = (M); \
            f32x4 v[4]; float s = 0.f; \
            _Pragma("unroll") for (int j = 0; j < 4; ++j) { const u32x4 xr_ = X[j]; const u32x2 h = H[j]; \
                const f32x4 x = L0 ? __builtin_bit_cast(f32x4, xr_) : (f32x4){bf_lo(xr_.x), bf_hi(xr_.x), bf_lo(xr_.y), bf_hi(xr_.y)}; \
                v[j] = (f32x4){ALPHA * x[0] + bf_lo(h.x), ALPHA * x[1] + bf_hi(h.x), ALPHA * x[2] + bf_lo(h.y), ALPHA * x[3] + bf_hi(h.y)}; \
                s += (v[j][0] + v[j][1]) + (v[j][2] + v[j][3]); } \
            const float mean = wave_sum_dpp(s) * (1.f / D); float s2 = 0.f; \
            _Pragma("unroll") for (int j = 0; j < 4; ++j) { v[j] = v[j] - mean; s2 += (v[j][0] * v[j][0] + v[j][1] * v[j][1]) + (v[j][2] * v[j][2] + v[j][3] * v[j][3]); } \
            const float rstd = 1.f / sqrtf(wave_sum_dpp(s2) * (1.f / D) + LN_EPS); \
            u32x2* ob = (u32x2*)(xb + (size_t)m * D) + lane; LAS u32x2* ot = (LAS u32x2*)(xt + (RJ) * RT_PITCH) + lane; \
            _Pragma("unroll") for (int j = 0; j < 4; ++j) { v[j] = v[j] * rstd * gv[j] + bv[j]; u32x2 w; w.x = cvt_pk_bf16(v[j][0], v[j][1]); w.y = cvt_pk_bf16(v[j][2], v[j][3]); if (m < T) ob[64 * j] = w; ot[64 * j] = w; } } while (0)
    LR_LOAD(xs0, hs0, gw); asm volatile("" ::: "memory"); LR_LOAD(xs1, hs1, gw + NGW); asm volatile("" ::: "memory"); LR_LOAD(xs2, hs2, gw + 2 * NGW); asm volatile("" ::: "memory");
    for (int m0 = gw; m0 < T; m0 += 4 * NGW) {
        LR_LOAD(xs3, hs3, m0 + 3 * NGW); asm volatile("" ::: "memory"); LR_ROW(xs0, hs0, 0, m0);
        LR_LOAD(xs0, hs0, m0 + 4 * NGW); asm volatile("" ::: "memory"); LR_ROW(xs1, hs1, 1, m0 + NGW);
        LR_LOAD(xs1, hs1, m0 + 5 * NGW); asm volatile("" ::: "memory"); LR_ROW(xs2, hs2, 2, m0 + 2 * NGW);
        LR_LOAD(xs2, hs2, m0 + 6 * NGW); asm volatile("" ::: "memory"); LR_ROW(xs3, hs3, 3, m0 + 3 * NGW);
        LDS_WAIT();
        f32x4 acc = {0.f, 0.f, 0.f, 0.f};
#pragma unroll 8
        for (int sk = 0; sk < 32; ++sk) { bf16x8 af, bh, bl; const unsigned xo = xa + sk * 64, wo = wa + sk * 64; LDS_RD128(af, xo, 0); LDS_RD128(bh, wo, 0); LDS_RD128(bl, wo, RT_WLO);
            asm volatile("s_waitcnt lgkmcnt(0)" : "+v"(af), "+v"(bh), "+v"(bl));
            acc = __builtin_amdgcn_mfma_f32_16x16x32_bf16(af, bh, acc, 0, 0, 0); acc = __builtin_amdgcn_mfma_f32_16x16x32_bf16(af, bl, acc, 0, 0, 0); }
#pragma unroll
        for (int i = 0; i < 4; ++i) { const int m = m0 + i * NGW; float x = acc[i];
            float mx = x; mx = fmaxf(mx, __builtin_bit_cast(float, __builtin_amdgcn_update_dpp(0, __builtin_bit_cast(int, mx), 0xB1, 0xf, 0xf, false)));
            mx = fmaxf(mx, __builtin_bit_cast(float, __builtin_amdgcn_update_dpp(0, __builtin_bit_cast(int, mx), 0x4E, 0xf, 0xf, false)));
            mx = fmaxf(mx, __builtin_bit_cast(float, __builtin_amdgcn_update_dpp(0, __builtin_bit_cast(int, mx), 0x141, 0xf, 0xf, false)));
            mx = fmaxf(mx, __builtin_bit_cast(float, __builtin_amdgcn_update_dpp(0, __builtin_bit_cast(int, mx), 0x140, 0xf, 0xf, false)));
            const float p = __expf(x - mx); float sm = p;
            sm = dpp_add<0xB1, 0xf>(sm); sm = dpp_add<0x4E, 0xf>(sm); sm = dpp_add<0x141, 0xf>(sm); sm = dpp_add<0x140, 0xf>(sm);
            if (lane < 16 && m < T) { const int b = m >> 13, t = m & (SEQ - 1); afft[((size_t)(b * NE + lane) << 13) + t] = p / sm; inv[(size_t)m * NE + lane] = -1; } }
    }
#undef LR_LOAD
#undef LR_ROW
}

__device__ __forceinline__ void topk_unit(KArgs a, int list, LAS unsigned char* lds, int tid, int wave, int lane) {
    unsigned char* ws = a->ws;
    const float* src = (const float*)(ws + WS_AFFT) + (size_t)list * SEQ;
    int* selt = (int*)(ws + WS_SELT); float* selg = (float*)(ws + WS_SELG); int* inv = (int*)(ws + WS_INV);
    const int b = list >> 4, e = list & 15;
    LAS unsigned* hist = (LAS unsigned*)lds;
    LAS unsigned* sc = hist + 2048;
    LAS unsigned* wtot = hist + 2048 + 64;
    unsigned key[16];
#pragma unroll
    for (int j = 0; j < 4; ++j) { const u32x4 v = *((const u32x4*)(src + tid * 16) + j); key[4 * j] = v.x; key[4 * j + 1] = v.y; key[4 * j + 2] = v.z; key[4 * j + 3] = v.w; }
    unsigned prefix = 0, need = CAP;
#pragma unroll
    for (int pass = 0; pass < 3; ++pass) {
        const int shift = (pass == 0) ? 21 : (pass == 1) ? 10 : 0; const int nb = (pass == 2) ? 1024 : 2048; const int per = nb / 64;
#pragma unroll
        for (int q = 0; q < 4; ++q) hist[tid + q * 512] = 0u;
        __syncthreads();
#pragma unroll
        for (int j = 0; j < 16; ++j) { const unsigned k = key[j]; const bool match = (pass == 0) || ((pass == 1 ? (k >> 21) : (k >> 10)) == prefix); if (match) __hip_atomic_fetch_add(&hist[(k >> shift) & (unsigned)(nb - 1)], 1u, __ATOMIC_RELAXED, __HIP_MEMORY_SCOPE_WORKGROUP); }
        __syncthreads();
        if (wave == 0) {
            unsigned s = 0; const int top = nb - 1 - per * lane;
            for (int q = 0; q < per; ++q) s += hist[top - q];
            unsigned incl = s;
#pragma unroll
            for (int o = 1; o < 64; o <<= 1) { const unsigned t = (unsigned)__builtin_amdgcn_ds_bpermute((lane - o) << 2, (int)incl); if (lane >= o) incl += t; }
            const unsigned long long bal = __ballot(incl >= need);
            const int first = __ffsll((long long)bal) - 1;
            if (lane == first) { unsigned before = incl - s; int q = 0;
                for (q = 0; q < per - 1; ++q) { const unsigned c = hist[top - q]; if (before + c >= need) break; before += c; }
                sc[0] = (prefix << (pass == 2 ? 10 : 11)) | (unsigned)(top - q); sc[1] = need - before; }
        }
        __syncthreads();
        prefix = sc[0]; need = sc[1];
        __syncthreads();
    }
    const unsigned thr = prefix;
    unsigned cg = 0, ce = 0;
#pragma unroll
    for (int j = 0; j < 16; ++j) { cg += key[j] > thr ? 1u : 0u; ce += key[j] == thr ? 1u : 0u; }
    unsigned ig = cg, ie = ce;
#pragma unroll
    for (int o = 1; o < 64; o <<= 1) { const unsigned t1 = (unsigned)__builtin_amdgcn_ds_bpermute((lane - o) << 2, (int)ig), t2 = (unsigned)__builtin_amdgcn_ds_bpermute((lane - o) << 2, (int)ie); if (lane >= o) { ig += t1; ie += t2; } }
    if (lane == 63) { wtot[wave] = ig; wtot[8 + wave] = ie; }
    __syncthreads();
    unsigned bg = 0, be = 0;
    for (int w = 0; w < wave; ++w) { bg += wtot[w]; be += wtot[8 + w]; }
    unsigned pg = bg + ig - cg, pe = be + ie - ce;
    const unsigned totalG = CAP - need;
#pragma unroll
    for (int j = 0; j < 16; ++j) { const unsigned k = key[j]; int slot = -1;
        if (k > thr) { slot = (int)pg; ++pg; } else if (k == thr) { if (pe < need) slot = (int)(totalG + pe); ++pe; }
        if (slot >= 0) { const int tok = b * SEQ + tid * 16 + j; const int r = b * CAP + slot;
            selt[e * EROWS + r] = tok; selg[e * EROWS + r] = __uint_as_float(k); inv[(size_t)tok * NE + e] = r; } }
    __syncthreads();
}

#define CL_ISSUE_Y(MYR, Y, W, REST) do { unsigned long long _bal = __ballot((MYR) >= 0) & 0xffffull; \
        _Pragma("unroll") for (int s_ = 0; s_ < 4; ++s_) { const u32x2* yr_ = (const u32x2*)y + lane; W[s_] = 0.f; \
            if (_bal) { const int e_ = __ffsll((long long)_bal) - 1; _bal &= _bal - 1; const int r_ = __builtin_amdgcn_readlane((MYR), e_); yr_ = (const u32x2*)(y + ((size_t)e_ * EROWS + r_) * D) + lane; W[s_] = 1.f; } \
            _Pragma("unroll") for (int j = 0; j < 4; ++j) Y[s_][j] = yr_[64 * j]; } \
        REST = _bal; } while (0)
__device__ __forceinline__ void phase_combine_ln(KArgs a, int l, int gw, int NGW, int lane) {
    unsigned char* ws = a->ws;
    const bf16_t* y = (const bf16_t*)(ws + WS_QKV); const int* inv = (const int*)(ws + WS_INV);
    float* xf = a->out; bf16_t* xb = (bf16_t*)(ws + WS_XB);
    const float* lg = a->in[I_LNFG] + (size_t)l * D; const float* lb = a->in[I_LNFB] + (size_t)l * D;
    f32x4 gv[4], bv[4];
#pragma unroll
    for (int j = 0; j < 4; ++j) { gv[j] = *((const f32x4*)lg + lane + 64 * j); bv[j] = *((const f32x4*)lb + lane + 64 * j); }
    const int el = lane & 15;
    u32x2 xC[4], xB[4], xA[4]; u32x2 yC[4][4], yB[4][4]; float wC[4], wB[4]; unsigned long long restC = 0, restB = 0; int myrC = -1, myrB = -1, myrA = -1;
    if (gw < T) { myrC = inv[(size_t)gw * NE + el];
#pragma unroll
        for (int j = 0; j < 4; ++j) xC[j] = *((const u32x2*)(xb + (size_t)gw * D) + lane + 64 * j);
        CL_ISSUE_Y(myrC, yC, wC, restC); }
    if (gw + NGW < T) { const int m1 = gw + NGW; myrB = inv[(size_t)m1 * NE + el];
#pragma unroll
        for (int j = 0; j < 4; ++j) xB[j] = *((const u32x2*)(xb + (size_t)m1 * D) + lane + 64 * j); }
    for (int m = gw; m < T; m += NGW) {
        const int mn = m + NGW, mnn = m + 2 * NGW;
        if (mn < T) CL_ISSUE_Y(myrB, yB, wB, restB);
        if (mnn < T) { myrA = inv[(size_t)mnn * NE + el];
#pragma unroll
            for (int j = 0; j < 4; ++j) xA[j] = *((const u32x2*)(xb + (size_t)mnn * D) + lane + 64 * j); }
        f32x4 v[4];
#pragma unroll
        for (int j = 0; j < 4; ++j) v[j] = (f32x4){bf_lo(xC[j].x), bf_hi(xC[j].x), bf_lo(xC[j].y), bf_hi(xC[j].y)} * ALPHA;
#pragma unroll
        for (int s_ = 0; s_ < 4; ++s_) { const float w = wC[s_];
#pragma unroll
            for (int j = 0; j < 4; ++j) { const u32x2 h = yC[s_][j]; v[j][0] += w * bf_lo(h.x); v[j][1] += w * bf_hi(h.x); v[j][2] += w * bf_lo(h.y); v[j][3] += w * bf_hi(h.y); } }
        while (restC) { const int e = __ffsll((long long)restC) - 1; restC &= restC - 1; const int r = __builtin_amdgcn_readlane(myrC, e);
            const u32x2* yr = (const u32x2*)(y + ((size_t)e * EROWS + r) * D) + lane;
#pragma unroll
            for (int j = 0; j < 4; ++j) { const u32x2 h = yr[64 * j]; v[j][0] += bf_lo(h.x); v[j][1] += bf_hi(h.x); v[j][2] += bf_lo(h.y); v[j][3] += bf_hi(h.y); } }
        float s = 0.f;
#pragma unroll
        for (int j = 0; j < 4; ++j) s += (v[j][0] + v[j][1]) + (v[j][2] + v[j][3]);
        const float mean = wave_sum_dpp(s) * (1.f / D); float s2 = 0.f;
#pragma unroll
        for (int j = 0; j < 4; ++j) { v[j] = v[j] - mean; s2 += (v[j][0] * v[j][0] + v[j][1] * v[j][1]) + (v[j][2] * v[j][2] + v[j][3] * v[j][3]); }
        const float rstd = 1.f / sqrtf(wave_sum_dpp(s2) * (1.f / D) + LN_EPS);
        f32x4* of = (f32x4*)(xf + (size_t)m * D) + lane; u32x2* ob = (u32x2*)(xb + (size_t)m * D) + lane;
#pragma unroll
        for (int j = 0; j < 4; ++j) { v[j] = v[j] * rstd * gv[j] + bv[j]; if (l == DEPTH - 1) of[64 * j] = v[j]; else { u32x2 w; w.x = cvt_pk_bf16(v[j][0], v[j][1]); w.y = cvt_pk_bf16(v[j][2], v[j][3]); ob[64 * j] = w; } }
#pragma unroll
        for (int j = 0; j < 4; ++j) { xC[j] = xB[j]; xB[j] = xA[j]; }
#pragma unroll
        for (int s_ = 0; s_ < 4; ++s_) { wC[s_] = wB[s_];
#pragma unroll
            for (int j = 0; j < 4; ++j) yC[s_][j] = yB[s_][j]; }
        restC = restB; myrC = myrB; myrB = myrA;
    }
}
#undef CL_ISSUE_Y

__device__ __forceinline__ void qkt(f32x16& p0, f32x16& p1, lds_cptr Kslot, const bf16x8* qr, int r32, int hi) {
    lds_cptr kb = Kslot + hi * 1024 + r32 * 16;
    p0 = f32x16{}; p1 = f32x16{};
#pragma unroll
    for (int d0 = 0; d0 < 4; ++d0) {
        const bf16x8 b0 = *(const LAS bf16x8*)(kb + d0 * 2048);
        const bf16x8 b1 = *(const LAS bf16x8*)(kb + d0 * 2048 + 512);
        p0 = __builtin_amdgcn_mfma_f32_32x32x16_bf16(b0, qr[d0], p0, 0, 0, 0);
        p1 = __builtin_amdgcn_mfma_f32_32x32x16_bf16(b1, qr[d0], p1, 0, 0, 0); }
}
__device__ __forceinline__ void pack_p(const f32x16& p0, const f32x16& p1, bf16x8& a0, bf16x8& a1, bf16x8& a2, bf16x8& a3) {
    u32x4 w0 = {cvt_pk_bf16(p0[0], p0[1]), cvt_pk_bf16(p0[2], p0[3]), cvt_pk_bf16(p0[4], p0[5]), cvt_pk_bf16(p0[6], p0[7])};
    u32x4 w1 = {cvt_pk_bf16(p0[8], p0[9]), cvt_pk_bf16(p0[10], p0[11]), cvt_pk_bf16(p0[12], p0[13]), cvt_pk_bf16(p0[14], p0[15])};
    u32x4 w2 = {cvt_pk_bf16(p1[0], p1[1]), cvt_pk_bf16(p1[2], p1[3]), cvt_pk_bf16(p1[4], p1[5]), cvt_pk_bf16(p1[6], p1[7])};
    u32x4 w3 = {cvt_pk_bf16(p1[8], p1[9]), cvt_pk_bf16(p1[10], p1[11]), cvt_pk_bf16(p1[12], p1[13]), cvt_pk_bf16(p1[14], p1[15])};
    a0 = __builtin_bit_cast(bf16x8, w0); a1 = __builtin_bit_cast(bf16x8, w1); a2 = __builtin_bit_cast(bf16x8, w2); a3 = __builtin_bit_cast(bf16x8, w3);
}
template <int NQ> __device__ __forceinline__ void pv_acc(f32x16* o, lds_cptr vp, bf16x8 a0, bf16x8 a1, bf16x8 a2, bf16x8 a3) {
#pragma unroll
    for (int d0 = 0; d0 < NQ; ++d0) { s16x4 lo[4], hi4[4];
#pragma unroll
        for (int ks = 0; ks < 4; ++ks) { lo[ks] = vtr(vp + d0 * 4096 + ks * 1024); hi4[ks] = vtr(vp + d0 * 4096 + ks * 1024 + 512); }
#define PKV(k) (bf16x8){lo[k][0], lo[k][1], lo[k][2], lo[k][3], hi4[k][0], hi4[k][1], hi4[k][2], hi4[k][3]}
        o[d0] = __builtin_amdgcn_mfma_f32_32x32x16_bf16(a0, PKV(0), o[d0], 0, 0, 0);
        o[d0] = __builtin_amdgcn_mfma_f32_32x32x16_bf16(a1, PKV(1), o[d0], 0, 0, 0);
        o[d0] = __builtin_amdgcn_mfma_f32_32x32x16_bf16(a2, PKV(2), o[d0], 0, 0, 0);
        o[d0] = __builtin_amdgcn_mfma_f32_32x32x16_bf16(a3, PKV(3), o[d0], 0, 0, 0);
        SBAR();
#undef PKV
    }
}
template <int NQ> __device__ __forceinline__ void softmax_step(f32x16& p0, f32x16& p1, float& m, float& l, f32x16* o, LAS float* wsf, int r32, int hi) {
    float rm = fmaxf(p0[0], p1[0]);
#pragma unroll
    for (int r = 1; r < 16; ++r) rm = fmaxf(rm, fmaxf(p0[r], p1[r]));
    rm = pl32_max(rm);
    if (__any(rm > m + 8.0f)) {
        const float mn = fmaxf(m, rm); const float al = __builtin_amdgcn_exp2f(m - mn); m = mn; l *= al;
        if (hi == 0) wsf[r32] = al;
        LDS_WAIT();
#pragma unroll
        for (int r = 0; r < 16; ++r) { const float f = wsf[crow(r, hi)];
#pragma unroll
            for (int d0 = 0; d0 < NQ; ++d0) o[d0][r] *= f; }
    }
    float s = 0.f;
#pragma unroll
    for (int r = 0; r < 16; ++r) { p0[r] = __builtin_amdgcn_exp2f(p0[r] - m); p1[r] = __builtin_amdgcn_exp2f(p1[r] - m); s += p0[r] + p1[r]; }
    l += s;
}

__device__ __forceinline__ void phase_key_norms(const bf16_t* qkv, float* kn, int gw, int NGW, int lane) {
    for (int item = gw; item < BATCH * 4 * 128; item += NGW) {
        const int b = item >> 9, h = (item >> 7) & 3, t = item & 127;
        const bf16_t* p = qkv + ((size_t)b * SEQ + t * 64 + (lane >> 4)) * QKVW + 2048 + h * 128 + (lane & 15) * 8;
        u32x4 x[16];
#pragma unroll
        for (int j = 0; j < 16; ++j) x[j] = *(const u32x4*)(p + (size_t)(4 * j) * QKVW);
        float mx = 0.f;
#pragma unroll
        for (int j = 0; j < 16; ++j) { const u32x4 v = x[j];
            float sq = bf_lo(v.x) * bf_lo(v.x) + bf_hi(v.x) * bf_hi(v.x) + bf_lo(v.y) * bf_lo(v.y) + bf_hi(v.y) * bf_hi(v.y) + bf_lo(v.z) * bf_lo(v.z) + bf_hi(v.z) * bf_hi(v.z) + bf_lo(v.w) * bf_lo(v.w) + bf_hi(v.w) * bf_hi(v.w);
            sq = dpp_add<0xB1, 0xf>(sq); sq = dpp_add<0x4E, 0xf>(sq); sq = dpp_add<0x141, 0xf>(sq);
            mx = fmaxf(mx, sq); }
        const float n = wave_max(mx);
        if (lane == 0) kn[item] = sqrtf(n) * 1.001f;
    }
}

#define MX3(a, b, c) __builtin_fmaxf(__builtin_fmaxf((a), (b)), (c))
constexpr int DA_LIST_OFF = 81920;
__device__ __forceinline__ void diff_attn_unit(const bf16_t* qkv, bf16_t* mix, const float* kn, int b, int h, int qb, float lam, float sl2, const float* subg, float outscale,
                                               LAS unsigned char* lds, int tid, int wid, int lane) {
    const int r32 = lane & 31, hi = lane >> 5, mp = wid >> 2, rg = wid & 3;
    const size_t rowbase = (size_t)b * SEQ; const int q0 = qb * 128;
    LAS float* wsf = (LAS float*)(lds + SCR_OFF + wid * 512);
    LAS int* lst = (LAS int*)(lds + DA_LIST_OFF);
    const unsigned lds0 = (unsigned)(uintptr_t)lds;
    const char* kvb = (const char*)(qkv + rowbase * QKVW);
    const int td0 = q0 >> 6;
    const int kcol = 2048 + h * 128 + (wid >> 2) * 64 + (4 * ((wid & 3) >> 1) + ((lane & 3) ^ ((lane >> 4) & 3))) * 8;
    const unsigned koff = (unsigned)((32 * (wid & 1) + (lane >> 2)) * QKVW + kcol) * 2u;
    const unsigned voff = (unsigned)((16 * ((2 * wid) & 3) + (lane >> 2)) * QKVW + 2560 + h * 128 + ((2 * wid) >> 2) * 32 + (lane & 3) * 8) * 2u;
    const unsigned koffR = (unsigned)((63 - (32 * (wid & 1) + (lane >> 2))) * QKVW + kcol) * 2u;
    const unsigned voffR = (unsigned)((63 - (16 * ((2 * wid) & 3) + (lane >> 2))) * QKVW + 2560 + h * 128 + ((2 * wid) >> 2) * 32 + (lane & 3) * 8) * 2u;
#define DA_GL(src, voff_, dst) glds16s((src), (voff_), (unsigned)__builtin_amdgcn_readfirstlane((int)(dst)))
#define DA_DMA(t, kbuf, vbuf) do { const char* _tb = kvb + (size_t)(t) * (64 * QKVW * 2); const unsigned _kd = lds0 + (kbuf) * 16384 + wid * 2048, _vd = lds0 + 32768 + (vbuf) * 16384 + wid * 2048; \
        if ((t) > td0 + 1) { DA_GL(_tb, koffR, _kd); DA_GL(_tb - 16 * QKVW * 2, koffR, _kd + 1024); DA_GL(_tb, voffR, _vd); DA_GL(_tb - 16 * QKVW * 2, voffR, _vd + 1024); } \
        else { DA_GL(_tb, koff, _kd); DA_GL(_tb + 16 * QKVW * 2, koff, _kd + 1024); DA_GL(_tb, voff, _vd); DA_GL(_tb + 16 * QKVW * 2, voff, _vd + 1024); } } while (0)
#define DA_DMA_K(t, kbuf) do { const char* _tb = kvb + (size_t)(t) * (64 * QKVW * 2); const unsigned _kd = lds0 + (kbuf) * 16384 + wid * 2048; \
        if ((t) > td0 + 1) { DA_GL(_tb, koffR, _kd); DA_GL(_tb - 16 * QKVW * 2, koffR, _kd + 1024); } else { DA_GL(_tb, koff, _kd); DA_GL(_tb + 16 * QKVW * 2, koff, _kd + 1024); } } while (0)
#define DA_DMA_V(t, vbuf) do { const char* _tb = kvb + (size_t)(t) * (64 * QKVW * 2); const unsigned _vd = lds0 + 32768 + (vbuf) * 16384 + wid * 2048; \
        if ((t) > td0 + 1) { DA_GL(_tb, voffR, _vd); DA_GL(_tb - 16 * QKVW * 2, voffR, _vd + 1024); } else { DA_GL(_tb, voff, _vd); DA_GL(_tb + 16 * QKVW * 2, voff, _vd + 1024); } } while (0)
    DA_DMA(td0, 0, 0);
    float kn0 = 0.f, kn1 = 0.f; if (wid == 0) { const float* knp = kn + (b * 4 + h) * 128; kn0 = knp[lane]; kn1 = knp[lane + 64]; }
    const int tspec = (td0 > 0) ? td0 - 1 : td0 + 2;
    const bf16_t* Qw = qkv + (rowbase + q0 + rg * 32 + r32) * QKVW + 1536 + h * 128 + mp * 64 + hi * 8;
    bf16x8 qr[4];
#pragma unroll
    for (int d0 = 0; d0 < 4; ++d0) qr[d0] = *(const bf16x8*)(Qw + d0 * 16);
    {
      float qs = 0.f;
#pragma unroll
      for (int d0 = 0; d0 < 4; ++d0) { const u32x4 w = __builtin_bit_cast(u32x4, qr[d0]);
          qs += bf_lo(w.x) * bf_lo(w.x) + bf_hi(w.x) * bf_hi(w.x) + bf_lo(w.y) * bf_lo(w.y) + bf_hi(w.y) * bf_hi(w.y) + bf_lo(w.z) * bf_lo(w.z) + bf_hi(w.z) * bf_hi(w.z) + bf_lo(w.w) * bf_lo(w.w) + bf_hi(w.w) * bf_hi(w.w); }
      qs = wave_max(pl32_sum(qs));
      if (lane == 0) wsf[64] = sqrtf(qs) * 1.001f; }
    f32x16 o[4];
#pragma unroll
    for (int d0 = 0; d0 < 4; ++d0) o[d0] = f32x16{};
    float m = -1e30f, l = 0.f;
    const int iq = q0 + rg * 32 + r32;
    const int vlane = ((lane >> 4) & 1) * 32 + (lane & 3) * 8 + (4 * hi + ((lane & 15) >> 2)) * 64;
    bf16x8 a0, a1, a2, a3;
    int vb = 0, vbp = 0;
#define DA_STEP(GENERAL, CPAT, T_, HASN_, TN_) do { \
        const int kb = it & 1; const int t = (T_); \
        VM_WAIT(); __syncthreads();                                 \
        const int vbn = (vb == 2) ? 0 : vb + 1; \
        const unsigned Kb_ = lds0 + kb * 16384 + mp * 8192 + (r32 >> 4) * 1024 + (r32 & 15) * 64; const unsigned Ka0 = Kb_ + ((hi ^ ((r32 >> 2) & 3)) << 4), Ka1 = Kb_ + (((2 + hi) ^ ((r32 >> 2) & 3)) << 4); \
        const unsigned va = lds0 + 32768 + ((mp == 1) ? vbp : vb) * 16384 + vlane;         \
        bf16x8 k0, k1, k2, k3, k4, k5, k6, k7; s16x4 xl0, xl1, xl2, xl3, xh0, xh1, xh2, xh3, yl0, yl1, yl2, yl3, yh0, yh1, yh2, yh3; \
        if (mp == 1 && it > 0) { PV_RD(xl, xh, 0); PV_RD(yl, yh, 1); PV_WAIT(8, xl, xh); __builtin_amdgcn_s_setprio(1); PV_MM(xl, xh, 0); PV_RD(xl, xh, 2); PV_WAIT(8, yl, yh); PV_MM(yl, yh, 1); PV_RD(yl, yh, 3); PV_WAIT(8, xl, xh); PV_MM(xl, xh, 2); PV_WAIT(0, yl, yh); PV_MM(yl, yh, 3); __builtin_amdgcn_s_setprio(0); } \
          \
        LDS_RD128(k0, Ka0, 0); LDS_RD128(k1, Ka0, 2048); LDS_RD128(k2, Ka1, 0); LDS_RD128(k3, Ka1, 2048); \
        if (HASN_) { const int tn = (TN_); DA_DMA_K(tn, kb ^ 1); } \
        f32x16 p0, p1; float A0, A1; \
        asm volatile("s_waitcnt lgkmcnt(2)" : "+v"(k0), "+v"(k1)); __builtin_amdgcn_s_setprio(1); \
        p0 = __builtin_amdgcn_mfma_f32_32x32x16_bf16(k0, qr[0], CPAT, 0, 0, 0); p1 = __builtin_amdgcn_mfma_f32_32x32x16_bf16(k1, qr[0], CPAT, 0, 0, 0); \
        asm volatile("" : "+v"(p0), "+v"(p1)); LDS_RD128(k4, Ka0, 4096); LDS_RD128(k5, Ka0, 6144); \
        asm volatile("s_waitcnt lgkmcnt(2)" : "+v"(k2), "+v"(k3)); \
        p0 = __builtin_amdgcn_mfma_f32_32x32x16_bf16(k2, qr[1], p0, 0, 0, 0); p1 = __builtin_amdgcn_mfma_f32_32x32x16_bf16(k3, qr[1], p1, 0, 0, 0); \
        asm volatile("" : "+v"(p0), "+v"(p1)); LDS_RD128(k6, Ka1, 4096); LDS_RD128(k7, Ka1, 6144); \
        asm volatile("s_waitcnt lgkmcnt(2)" : "+v"(k4), "+v"(k5)); \
        p0 = __builtin_amdgcn_mfma_f32_32x32x16_bf16(k4, qr[2], p0, 0, 0, 0); p1 = __builtin_amdgcn_mfma_f32_32x32x16_bf16(k5, qr[2], p1, 0, 0, 0); \
        asm volatile("s_waitcnt lgkmcnt(0)" : "+v"(k6), "+v"(k7)); \
        p0 = __builtin_amdgcn_mfma_f32_32x32x16_bf16(k6, qr[3], p0, 0, 0, 0); p1 = __builtin_amdgcn_mfma_f32_32x32x16_bf16(k7, qr[3], p1, 0, 0, 0); \
        asm volatile("" : "+v"(p0), "+v"(p1)); __builtin_amdgcn_s_setprio(0); \
        if (mp == 0) PV_RD(xl, xh, 0);                              \
        if (GENERAL) { A0 = 0.f; A1 = 0.f; const float di0 = (float)(iq - t * 64 - 4 * hi); \
            _Pragma("unroll") for (int r = 0; r < 16; ++r) { const float c = (float)((r & 3) + 8 * (r >> 2)); p0[r] -= sl2 * fabsf(di0 - c); p1[r] -= sl2 * fabsf(di0 - 32.f - c); } } \
        else { const int dd = (t < td0) ? (iq - t * 64) : (t * 64 + 63 - iq); A0 = -sl2 * (float)(dd - 4 * hi); A1 = A0 + 32.f * sl2; } \
          \
        float x0 = MX3(p0[0], p0[1], p0[2]), x1 = MX3(p1[0], p1[1], p1[2]); \
        _Pragma("unroll") for (int r = 3; r < 15; r += 2) { x0 = MX3(x0, p0[r], p0[r + 1]); x1 = MX3(x1, p1[r], p1[r + 1]); } \
        x0 = fmaxf(x0, p0[15]); x1 = fmaxf(x1, p1[15]); \
        const float rm = pl32_max(fmaxf(x0 + A0, x1 + A1)); \
        if (__any(rm > m + 8.0f)) { \
            const float mn = fmaxf(m, rm); const float al = __builtin_amdgcn_exp2f(m - mn); m = mn; l *= al; \
            if (hi == 0) wsf[r32] = al; \
            LDS_WAIT(); \
            _Pragma("unroll") for (int r = 0; r < 16; ++r) { const float f = wsf[crow(r, hi)]; \
                _Pragma("unroll") for (int d0 = 0; d0 < 4; ++d0) o[d0][r] *= f; } \
        } \
        { const float mm0 = m - A0, mm1 = m - A1; float s0 = 0.f, s1 = 0.f; \
          _Pragma("unroll") for (int r = 0; r < 16; ++r) { p0[r] = __builtin_amdgcn_exp2f(p0[r] - mm0); p1[r] = __builtin_amdgcn_exp2f(p1[r] - mm1); s0 += p0[r]; s1 += p1[r]; } \
          l += s0 + s1; } \
        pack_p(p0, p1, a0, a1, a2, a3); \
        asm volatile("" : "+v"(a0), "+v"(a1), "+v"(a2), "+v"(a3)); \
        if (HASN_) { const int tn = (TN_); DA_DMA_V(tn, vbn); }        \
        if (mp == 0) { PV_RD(yl, yh, 1); PV_WAIT(8, xl, xh); __builtin_amdgcn_s_setprio(1); PV_MM(xl, xh, 0); PV_RD(xl, xh, 2); PV_WAIT(8, yl, yh); PV_MM(yl, yh, 1); PV_RD(yl, yh, 3); PV_WAIT(8, xl, xh); PV_MM(xl, xh, 2); PV_WAIT(0, yl, yh); PV_MM(yl, yh, 3); __builtin_amdgcn_s_setprio(0); } \
        vbp = vb; vb = vbn; } while (0)
    { const f32x16 zc = f32x16{};
      _Pragma("nounroll") for (int it = 0; it < 2; ++it) DA_STEP(true, zc, td0 + it, true, (it == 0 ? td0 + 1 : tspec)); }
    { const float mw = -wave_max(-m);
      const float lw = -wave_max(-pl32_sum(l));
      if (lane == 0) { wsf[65] = mw; wsf[66] = lw; } }
    LDS_WAIT(); __syncthreads();
    if (wid == 0) {
        float qnw[8], mnw[8], lmin = 1e30f;
#pragma unroll
        for (int w = 0; w < 8; ++w) { const LAS float* ws2 = (const LAS float*)(lds + SCR_OFF + w * 512); qnw[w] = ws2[64]; mnw[w] = ws2[65]; lmin = fminf(lmin, ws2[66]); }
        const float kfac = uni_f(__builtin_amdgcn_logf((1.0f - __builtin_amdgcn_exp2f(-64.0f * sl2)) / (1.0f - __builtin_amdgcn_exp2f(-sl2))) + 0.002f);
        bool keep[2]; float ew[2];
#pragma unroll
        for (int j = 0; j < 2; ++j) { const int t = lane + 64 * j; const float knt = j ? kn1 : kn0; float e = -1e30f;
#pragma unroll
            for (int w = 0; w < 8; ++w) { const int rgw = w & 3; const int dw = (t < td0) ? 64 * (td0 - t) - 63 + 32 * rgw : 64 * (t - td0 - 2) + 97 - 32 * rgw;
                e = fmaxf(e, qnw[w] * knt - sl2 * (float)dw - mnw[w]); }
            ew[j] = (t != td0 && t != td0 + 1) ? e + 0.0625f + kfac : 1e30f; }
        float tau = -12.0f;
        _Pragma("nounroll") for (int k = 0; k < 56; ++k) {
            const float sl = (ew[0] < tau ? __builtin_amdgcn_exp2f(ew[0]) : 0.f) + (ew[1] < tau ? __builtin_amdgcn_exp2f(ew[1]) : 0.f);
            const float S = uni_f(wave_sum(sl));
            if (S <= 5.9604645e-8f * lmin) break;
            tau -= 0.5f; }
#pragma unroll
        for (int j = 0; j < 2; ++j) keep[j] = (ew[j] < 1e29f) && !(ew[j] < tau);
        unsigned long long b0 = __ballot(keep[0]), b1 = __ballot(keep[1]);
        const int ksel = (int)(((tspec < 64 ? b0 >> tspec : b1 >> (tspec - 64)) & 1ull));
        if (tspec < 64) b0 &= ~(1ull << tspec); else b1 &= ~(1ull << (tspec - 64));
        const unsigned long long below = (1ull << lane) - 1ull;
        const int n0 = __popcll(b0);
        if ((b0 >> lane) & 1ull) lst[ksel + __popcll(b0 & below)] = lane;
        if ((b1 >> lane) & 1ull) lst[ksel + n0 + __popcll(b1 & below)] = lane + 64;
        if (lane == 0) { lst[128] = ksel + n0 + __popcll(b1); lst[129] = ksel; if (ksel) lst[0] = tspec; }
    }
    LDS_WAIT(); __syncthreads();
    const int NTL = __builtin_amdgcn_readfirstlane(lst[128]);
    f32x16 patL;
#pragma unroll
    for (int r = 0; r < 16; ++r) patL[r] = sl2 * (float)((r & 3) + 8 * (r >> 2));
    asm volatile("" : "+v"(patL));
    if (NTL > 0 && __builtin_amdgcn_readfirstlane(lst[129]) == 0) { const int t0 = __builtin_amdgcn_readfirstlane(lst[0]); DA_DMA(t0, 0, vb); }
    _Pragma("nounroll") for (int it = 2; it < 2 + NTL; ++it) { const int tcur = __builtin_amdgcn_readfirstlane(lst[it - 2]); const bool hasn = (it - 1 < NTL);
        const int tnx = hasn ? __builtin_amdgcn_readfirstlane(lst[it - 1]) : 0;
        DA_STEP(false, patL, tcur, hasn, tnx); }
#undef DA_STEP
    if (mp == 1) { const unsigned va = lds0 + 32768 + vbp * 16384 + vlane; s16x4 xl0, xl1, xl2, xl3, xh0, xh1, xh2, xh3, yl0, yl1, yl2, yl3, yh0, yh1, yh2, yh3;
        PV_RD(xl, xh, 0); PV_RD(yl, yh, 1); PV_WAIT(8, xl, xh); PV_MM(xl, xh, 0); PV_RD(xl, xh, 2); PV_WAIT(8, yl, yh); PV_MM(yl, yh, 1); PV_RD(yl, yh, 3); PV_WAIT(8, xl, xh); PV_MM(xl, xh, 2); PV_WAIT(0, yl, yh); PV_MM(yl, yh, 3); }
    l = pl32_sum(l);
    if (hi == 0) wsf[r32] = (mp ? lam : 1.0f) / l;
    LDS_WAIT(); VM_WAIT();
    __syncthreads();
    LAS float* xch = (LAS float*)(lds + rg * 16384);
    if (mp == 1) {
#pragma unroll
        for (int r = 0; r < 16; ++r) { const float f = wsf[crow(r, hi)];
#pragma unroll
            for (int d0 = 0; d0 < 4; ++d0) xch[crow(r, hi) * 128 + d0 * 32 + r32] = o[d0][r] * f; }
    }
    __syncthreads();
    if (mp == 0) {
        float ss[16];
#pragma unroll
        for (int r = 0; r < 16; ++r) { const float f1 = wsf[crow(r, hi)]; float sq = 0.f;
#pragma unroll
            for (int d0 = 0; d0 < 4; ++d0) { const float v = o[d0][r] * f1 - xch[crow(r, hi) * 128 + d0 * 32 + r32]; o[d0][r] = v; sq += v * v; }
            ss[r] = sq; }
#pragma unroll
        for (int r = 0; r < 16; ++r) { ss[r] = half_sum(ss[r]); ss[r] = outscale / sqrtf(ss[r] * (1.f / 128.f) + RMS_EPS); }
        float gcol[4];
#pragma unroll
        for (int d0 = 0; d0 < 4; ++d0) gcol[d0] = subg[h * 128 + d0 * 32 + r32];
        char* Ow = (char*)(mix + (rowbase + q0 + rg * 32) * D + 512 + h * 128);
        int hi2 = hi; asm volatile("" : "+v"(hi2));
        const unsigned ob = (unsigned)((4 * hi2) * D + r32) * 2u;
#pragma unroll
        for (int r = 0; r < 16; ++r) { const unsigned orow = (unsigned)((r & 3) + 8 * (r >> 2));
#pragma unroll
            for (int d0 = 0; d0 < 4; ++d0) { const float v = o[d0][r] * ss[r] * gcol[d0]; *(bf16_t*)(Ow + (ob + (orow * D + d0 * 32) * 2u)) = (bf16_t)(cvt_pk_bf16(v, 0.f) & 0xffffu); } }
    }
    __syncthreads();
#undef DA_DMA
#undef DA_DMA_K
#undef DA_DMA_V
#undef DA_GL
}
#undef MX3

__device__ __forceinline__ void natten_unit(const bf16_t* qkv, bf16_t* mix, int b, int r, LAS unsigned char* lds, int wid, int lane) {
    const int r32 = lane & 31, hi = lane >> 5, h = wid;
    const size_t rowbase = (size_t)b * SEQ;
    const int rs = min(max(r - 4, 0), 120);
    const unsigned lds0 = (unsigned)(uintptr_t)lds + wid * 16384;
    LAS float* wsf = (LAS float*)(lds + SCR_OFF + wid * 512);
    bf16x8 qr[2][4];
    const bf16_t* Qw = qkv + (rowbase + (size_t)r * 64 + r32) * QKVW + h * 64 + hi * 8;
#pragma unroll
    for (int hq = 0; hq < 2; ++hq)
#pragma unroll
        for (int d0 = 0; d0 < 4; ++d0) qr[hq][d0] = *(const bf16x8*)(Qw + (size_t)hq * 32 * QKVW + d0 * 16);
    f32x16 o[2][2];
#pragma unroll
    for (int hq = 0; hq < 2; ++hq) { o[hq][0] = f32x16{}; o[hq][1] = f32x16{}; }
    float m[2] = {-1e30f, -1e30f}, l[2] = {0.f, 0.f};
    const int vlane = ((lane >> 4) & 1) * 32 + (lane & 3) * 8 + (4 * hi + ((lane & 15) >> 2)) * 64;
    const unsigned nkoff0 = (unsigned)((lane >> 3) * QKVW + 512 + h * 64) * 2u + (unsigned)(((lane & 7) ^ (lane >> 4)) << 4), nkoff1 = (unsigned)((lane >> 3) * QKVW + 512 + h * 64) * 2u + (unsigned)(((lane & 7) ^ ((lane >> 4) + 4)) << 4);
    const unsigned nvoff = (unsigned)((lane >> 2) * QKVW + 1024 + h * 64 + (lane & 3) * 8) * 2u;
    unsigned kna[4];
#pragma unroll
    for (int j = 0; j < 4; ++j) kna[j] = lds0 + (unsigned)(r32 * 128 + (((2 * j + hi) ^ ((r32 >> 1) & 7)) << 4));
#define NA_DMA_K(I) do { const char* tb_ = uni_ptr(qkv + (rowbase + (size_t)(rs + (I)) * 64) * QKVW); \
        _Pragma("nounroll") for (int c = 0; c < 8; c += 2) { glds16s(tb_ + (size_t)c * 8 * QKVW * 2, nkoff0, (unsigned)__builtin_amdgcn_readfirstlane((int)(lds0 + c * 1024))); \
            glds16s(tb_ + (size_t)(c + 1) * 8 * QKVW * 2, nkoff1, (unsigned)__builtin_amdgcn_readfirstlane((int)(lds0 + (c + 1) * 1024))); } } while (0)
#define NA_DMA_V(I) do { const char* tb_ = uni_ptr(qkv + (rowbase + (size_t)(rs + (I)) * 64) * QKVW); \
        _Pragma("nounroll") for (int p = 0; p < 8; ++p) glds16s(tb_ + (16 * (p & 3)) * QKVW * 2 + (p >> 2) * 64, nvoff, (unsigned)__builtin_amdgcn_readfirstlane((int)(lds0 + 8192 + p * 1024))); } while (0)
    NA_DMA_K(0); NA_DMA_V(0);
    for (int i = 0; i < 8; ++i) {
        asm volatile("s_waitcnt vmcnt(8)" ::: "memory");
        const int dr = rs + i - r + 7;
        f32x16 pq[2][2];
#pragma unroll
        for (int hq = 0; hq < 2; ++hq) { const f32x16 zc = f32x16{}; qkt_na(pq[hq][0], pq[hq][1], kna, qr[hq], zc); }
        asm volatile("s_waitcnt lgkmcnt(0)" ::: "memory");
        if (i < 7) NA_DMA_K(i + 1);
#pragma unroll
        for (int hq = 0; hq < 2; ++hq) {
            f32x16 p0 = pq[hq][0], p1 = pq[hq][1]; bf16x8 a0, a1, a2, a3;
            const int c = 32 * hq + r32; const int cs = min(max(c - 8, 0), 48);
            const unsigned bb = (unsigned)(uintptr_t)(lds + RPB_OFF) + (unsigned)(NA_PADB + h * 465 + dr * 31 + 4 * hi - c + 15) * 4u;
            const unsigned pb = (unsigned)(uintptr_t)(lds + RPB_OFF) + (unsigned)(NA_PEN + 48 + 4 * hi - cs) * 4u;
#define NA_LIVE0(rr) (hq == 0 || (rr) >= 12)
#define NA_LIVE1(rr) (hq == 1 || (rr) < 4)
            float rm = -1e30f;
            { float bA[16], pA[16];
#pragma unroll
              for (int rr = 0; rr < 16; ++rr) { const int jc = (rr & 3) + 8 * (rr >> 2);
                  if (NA_LIVE0(rr)) { asm volatile("ds_read_b32 %0, %1 offset:%c2" : "=v"(bA[rr]) : "v"(bb), "i"(jc * 4) : "memory"); asm volatile("ds_read_b32 %0, %1 offset:%c2" : "=v"(pA[rr]) : "v"(pb), "i"(jc * 4) : "memory"); } }
              asm volatile("s_waitcnt lgkmcnt(0)" ::: "memory");
#pragma unroll
              for (int rr = 0; rr < 16; ++rr) if (NA_LIVE0(rr)) { asm volatile("" : "+v"(bA[rr]), "+v"(pA[rr])); p0[rr] = p0[rr] + bA[rr] + pA[rr]; rm = fmaxf(rm, p0[rr]); }
#pragma unroll
              for (int rr = 0; rr < 16; ++rr) { const int jc = (rr & 3) + 8 * (rr >> 2);
                  if (NA_LIVE1(rr)) { asm volatile("ds_read_b32 %0, %1 offset:%c2" : "=v"(bA[rr]) : "v"(bb), "i"((jc + 32) * 4) : "memory"); asm volatile("ds_read_b32 %0, %1 offset:%c2" : "=v"(pA[rr]) : "v"(pb), "i"((jc + 32) * 4) : "memory"); } }
              asm volatile("s_waitcnt lgkmcnt(0)" ::: "memory");
#pragma unroll
              for (int rr = 0; rr < 16; ++rr) if (NA_LIVE1(rr)) { asm volatile("" : "+v"(bA[rr]), "+v"(pA[rr])); p1[rr] = p1[rr] + bA[rr] + pA[rr]; rm = fmaxf(rm, p1[rr]); } }
            rm = pl32_max(rm);
            if (__any(rm > m[hq] + 8.0f)) {
                const float mn = fmaxf(m[hq], rm); const float al = __builtin_amdgcn_exp2f(m[hq] - mn); m[hq] = mn; l[hq] *= al;
                if (hi == 0) wsf[r32] = al;
                LDS_WAIT();
#pragma unroll
                for (int rr = 0; rr < 16; ++rr) { const float f = wsf[crow(rr, hi)]; o[hq][0][rr] *= f; o[hq][1][rr] *= f; }
            }
            { float sm = 0.f; const float mm = m[hq];
#pragma unroll
              for (int rr = 0; rr < 16; ++rr) { if (NA_LIVE0(rr)) { p0[rr] = __builtin_amdgcn_exp2f(p0[rr] - mm); sm += p0[rr]; } else p0[rr] = 0.f;
                  if (NA_LIVE1(rr)) { p1[rr] = __builtin_amdgcn_exp2f(p1[rr] - mm); sm += p1[rr]; } else p1[rr] = 0.f; }
              l[hq] += sm; }
            pack_p(p0, p1, a0, a1, a2, a3);
            { const unsigned va = lds0 + 8192 + vlane; s16x4 xl0, xl1, xl2, xl3, xh0, xh1, xh2, xh3, yl0, yl1, yl2, yl3, yh0, yh1, yh2, yh3;
              asm volatile("s_waitcnt lgkmcnt(0)" ::: "memory");
              if (hq == 0) { if (i < 7) asm volatile("s_waitcnt vmcnt(8)" ::: "memory"); else asm volatile("s_waitcnt vmcnt(0)" ::: "memory"); }
              PV_RD(xl, xh, 0); PV_RD(yl, yh, 1); PV_WAIT(8, xl, xh);
              if (hq == 0) { o[hq][0] = __builtin_amdgcn_mfma_f32_32x32x16_bf16(a0, PV_PK(xl0, xh0), o[hq][0], 0, 0, 0); o[hq][0] = __builtin_amdgcn_mfma_f32_32x32x16_bf16(a1, PV_PK(xl1, xh1), o[hq][0], 0, 0, 0); o[hq][0] = __builtin_amdgcn_mfma_f32_32x32x16_bf16(a2, PV_PK(xl2, xh2), o[hq][0], 0, 0, 0); }
              else { o[hq][0] = __builtin_amdgcn_mfma_f32_32x32x16_bf16(a1, PV_PK(xl1, xh1), o[hq][0], 0, 0, 0); o[hq][0] = __builtin_amdgcn_mfma_f32_32x32x16_bf16(a2, PV_PK(xl2, xh2), o[hq][0], 0, 0, 0); o[hq][0] = __builtin_amdgcn_mfma_f32_32x32x16_bf16(a3, PV_PK(xl3, xh3), o[hq][0], 0, 0, 0); }
              PV_WAIT(0, yl, yh);
              if (hq == 0) { o[hq][1] = __builtin_amdgcn_mfma_f32_32x32x16_bf16(a0, PV_PK(yl0, yh0), o[hq][1], 0, 0, 0); o[hq][1] = __builtin_amdgcn_mfma_f32_32x32x16_bf16(a1, PV_PK(yl1, yh1), o[hq][1], 0, 0, 0); o[hq][1] = __builtin_amdgcn_mfma_f32_32x32x16_bf16(a2, PV_PK(yl2, yh2), o[hq][1], 0, 0, 0); }
              else { o[hq][1] = __builtin_amdgcn_mfma_f32_32x32x16_bf16(a1, PV_PK(yl1, yh1), o[hq][1], 0, 0, 0); o[hq][1] = __builtin_amdgcn_mfma_f32_32x32x16_bf16(a2, PV_PK(yl2, yh2), o[hq][1], 0, 0, 0); o[hq][1] = __builtin_amdgcn_mfma_f32_32x32x16_bf16(a3, PV_PK(yl3, yh3), o[hq][1], 0, 0, 0); } }
#undef NA_LIVE0
#undef NA_LIVE1
        }
        LDS_WAIT();
        if (i < 7) NA_DMA_V(i + 1);
    }
#undef NA_DMA_K
#undef NA_DMA_V
#pragma unroll
    for (int hq = 0; hq < 2; ++hq) {
        const float lt = pl32_sum(l[hq]);
        if (hi == 0) wsf[r32] = 1.0f / lt;
        LDS_WAIT();
        char* Ow = (char*)(mix + (rowbase + (size_t)r * 64 + hq * 32) * D + h * 64);
        int hi2 = hi; asm volatile("" : "+v"(hi2));
        const unsigned ob = (unsigned)((4 * hi2) * D + r32) * 2u;
#pragma unroll
        for (int rr = 0; rr < 16; ++rr) { const unsigned orow = (unsigned)((rr & 3) + 8 * (rr >> 2)); const float f = wsf[orow + 4 * hi2];
#pragma unroll
            for (int d0 = 0; d0 < 2; ++d0) { const float v = o[hq][d0][rr] * f; *(bf16_t*)(Ow + (ob + (orow * D + d0 * 32) * 2u)) = (bf16_t)(cvt_pk_bf16(v, 0.f) & 0xffffu); } }
        LDS_WAIT();
    }
}

constexpr int SGU_SV_OFF = 32768, SGU_SV_PITCH = 144, SGU_ST_OFF = 106496;
__device__ __forceinline__ void sgu_unit(KArgs a, int li, int chunk, LAS unsigned char* lds, int tid, int wid, int lane) {
    unsigned char* ws = a->ws;
    const bf16_t* z = (const bf16_t*)(ws + WS_QKV) + (size_t)chunk * 128 * 2048; bf16_t* mix = (bf16_t*)(ws + WS_MIX) + (size_t)chunk * 128 * D;
    const bf16_t* wsb = (const bf16_t*)(ws + WS_WSB) + (size_t)li * 8 * 128 * 128;
    const float* lng = a->in[I_LNVG] + (size_t)li * D; const float* lnb = a->in[I_LNVB] + (size_t)li * D; const float* bs = a->in[I_BS] + (size_t)li * 8 * 128;
    LAS float* st = (LAS float*)(lds + SGU_ST_OFF); LAS float* svt = (LAS float*)(lds + SGU_SV_OFF);
    const unsigned lds0 = (unsigned)(uintptr_t)lds;
    const int r32 = lane & 31, hi = lane >> 5;
    LAS float* gl = (LAS float*)(lds + SGU_ST_OFF + 1024); LAS float* bl = gl + 1024;
    for (int i = tid; i < 1024; i += NWAVES * 64) { gl[i] = lng[i]; bl[i] = lnb[i]; }
#pragma unroll
    for (int hb = 0; hb < 2; ++hb) {
        u32x4 x0[8], x1[8];
#pragma unroll
        for (int rr = 0; rr < 8; ++rr) { const u32x4* vr = (const u32x4*)(z + (size_t)(wid * 16 + hb * 8 + rr) * 2048 + 1024) + lane * 2; x0[rr] = vr[0]; x1[rr] = vr[1]; }
#pragma unroll
        for (int rr = 0; rr < 8; ++rr) { float f[16];
            f[0] = bf_lo(x0[rr].x); f[1] = bf_hi(x0[rr].x); f[2] = bf_lo(x0[rr].y); f[3] = bf_hi(x0[rr].y); f[4] = bf_lo(x0[rr].z); f[5] = bf_hi(x0[rr].z); f[6] = bf_lo(x0[rr].w); f[7] = bf_hi(x0[rr].w);
            f[8] = bf_lo(x1[rr].x); f[9] = bf_hi(x1[rr].x); f[10] = bf_lo(x1[rr].y); f[11] = bf_hi(x1[rr].y); f[12] = bf_lo(x1[rr].z); f[13] = bf_hi(x1[rr].z); f[14] = bf_lo(x1[rr].w); f[15] = bf_hi(x1[rr].w);
            float sm = 0.f;
#pragma unroll
            for (int k = 0; k < 16; ++k) sm += f[k];
            const float mean = wave_sum_dpp(sm) * (1.f / 1024.f); float s2 = 0.f;
#pragma unroll
            for (int k = 0; k < 16; ++k) { const float d = f[k] - mean; s2 += d * d; }
            const float rstd = 1.f / sqrtf(wave_sum_dpp(s2) * (1.f / 1024.f) + LN_EPS);
            if (lane == 0) { const int row = wid * 16 + hb * 8 + rr; st[row * 2] = mean; st[row * 2 + 1] = rstd; } } }
    __syncthreads();
    const int tb = wid & 3, ch = wid >> 2;
    const int vlane = ((lane >> 4) & 1) * 32 + (lane & 3) * 8 + (4 * hi + ((lane & 15) >> 2)) * 64;
    const int srow = tid >> 2, scq = tid & 3;
    const float mean_s = st[srow * 2], rstd_s = st[srow * 2 + 1];
    const bf16_t* vrow0 = z + (size_t)srow * 2048 + 1024 + scq * 32;
    const bf16_t* wrow0 = wsb + ((size_t)(tb * 32 + r32)) * 128 + 4 * hi;
    u32x4 xv[4]; u32x2 aw[2][4][2];
#define SGU_LOAD(G, XV, AW) do { _Pragma("unroll") for (int q = 0; q < 4; ++q) XV[q] = *((const u32x4*)(vrow0 + (G) * 128) + q); \
        _Pragma("unroll") for (int sl = 0; sl < 2; ++sl) _Pragma("unroll") for (int ks = 0; ks < 4; ++ks) { \
            AW[sl][ks][0] = *(const u32x2*)(wrow0 + (size_t)(G) * 128 * 128 + sl * 64 + ks * 16); AW[sl][ks][1] = *(const u32x2*)(wrow0 + (size_t)(G) * 128 * 128 + sl * 64 + ks * 16 + 8); } } while (0)
    SGU_LOAD(0, xv, aw);
    for (int g = 0; g < 8; ++g) {
#pragma unroll
        for (int q = 0; q < 4; ++q) { const u32x4 x = xv[q]; const int c0 = g * 128 + scq * 32 + q * 8;
            const f32x4 g0 = *(const LAS f32x4*)(gl + c0), g1 = *(const LAS f32x4*)(gl + c0 + 4), b0 = *(const LAS f32x4*)(bl + c0), b1 = *(const LAS f32x4*)(bl + c0 + 4);
            float f[8] = {bf_lo(x.x), bf_hi(x.x), bf_lo(x.y), bf_hi(x.y), bf_lo(x.z), bf_hi(x.z), bf_lo(x.w), bf_hi(x.w)};
#pragma unroll
            for (int k = 0; k < 4; ++k) { f[k] = (f[k] - mean_s) * rstd_s * g0[k] + b0[k]; f[4 + k] = (f[4 + k] - mean_s) * rstd_s * g1[k] + b1[k]; }
            u32x4 w; w.x = cvt_pk_bf16(f[0], f[1]); w.y = cvt_pk_bf16(f[2], f[3]); w.z = cvt_pk_bf16(f[4], f[5]); w.w = cvt_pk_bf16(f[6], f[7]);
            *(LAS u32x4*)(lds + (srow >> 6) * 16384 + (scq * 4 + ((srow & 63) >> 4)) * 1024 + (srow & 15) * 64 + q * 16) = w; }
        u32x4 uu[4];
        { const u32x4* urow = (const u32x4*)(z + (size_t)srow * 2048 + g * 128 + scq * 32);
#pragma unroll
          for (int q = 0; q < 4; ++q) uu[q] = urow[q]; }
        u32x4 xn[4]; u32x2 an[2][4][2];
        if (g + 1 < 8) SGU_LOAD(g + 1, xn, an);
        const float bsv = bs[g * 128 + srow];
        __syncthreads();
        f32x16 o[2]; o[0] = f32x16{}; o[1] = f32x16{};
#pragma unroll
        for (int sl = 0; sl < 2; ++sl) {
            bf16x8 af[4];
#pragma unroll
            for (int ks = 0; ks < 4; ++ks) { u32x4 w = {aw[sl][ks][0].x, aw[sl][ks][0].y, aw[sl][ks][1].x, aw[sl][ks][1].y}; af[ks] = __builtin_bit_cast(bf16x8, w); }
            pv_asm<2>(o, lds0 + sl * 16384 + (2 * ch) * 4096 + vlane, af[0], af[1], af[2], af[3]);
        }
#pragma unroll
        for (int r = 0; r < 16; ++r) { const int t = tb * 32 + crow(r, hi);
#pragma unroll
            for (int d0 = 0; d0 < 2; ++d0) svt[t * SGU_SV_PITCH + ch * 64 + d0 * 32 + r32] = o[d0][r]; }
        __syncthreads();
        { const LAS f32x4* sp = (const LAS f32x4*)(svt + srow * SGU_SV_PITCH + scq * 32);
          u32x4* orow = (u32x4*)(mix + (size_t)srow * D + g * 128 + scq * 32);
#pragma unroll
          for (int q = 0; q < 4; ++q) { const f32x4 s0 = sp[2 * q], s1 = sp[2 * q + 1]; const u32x4 u = uu[q];
              u32x4 w; w.x = cvt_pk_bf16(bf_lo(u.x) * (s0[0] + bsv), bf_hi(u.x) * (s0[1] + bsv)); w.y = cvt_pk_bf16(bf_lo(u.y) * (s0[2] + bsv), bf_hi(u.y) * (s0[3] + bsv));
              w.z = cvt_pk_bf16(bf_lo(u.z) * (s1[0] + bsv), bf_hi(u.z) * (s1[1] + bsv)); w.w = cvt_pk_bf16(bf_lo(u.w) * (s1[2] + bsv), bf_hi(u.w) * (s1[3] + bsv));
              orow[q] = w; } }
#pragma unroll
        for (int q = 0; q < 4; ++q) xv[q] = xn[q];
#pragma unroll
        for (int sl = 0; sl < 2; ++sl)
#pragma unroll
            for (int ks = 0; ks < 4; ++ks) { aw[sl][ks][0] = an[sl][ks][0]; aw[sl][ks][1] = an[sl][ks][1]; }
    }
#undef SGU_LOAD
    __syncthreads();
}

constexpr int PH_PER_LAYER = 9, N_PHASES = 1 + DEPTH * PH_PER_LAYER;
__global__ void __launch_bounds__(NWAVES * 64, 2) enc_fwd(Args args) {
    extern __shared__ __attribute__((aligned(16))) unsigned char lds_raw[];
    LAS unsigned char* lds = (LAS unsigned char*)lds_raw;
    volatile LAS unsigned* MISC = (volatile LAS unsigned*)(lds + MISC_OFF);
    const int tid = threadIdx.x, lane = tid & 63, wave = __builtin_amdgcn_readfirstlane(tid >> 6);
    const int G = gridDim.x; const int bx = blockIdx.x; const int vcu = (G % 8 == 0) ? (bx % 8) * (G / 8) + bx / 8 : bx;
    const int gw = vcu * NWAVES + wave, NGW = G * NWAVES;
    unsigned char* ws = args.ws;
    unsigned* ctl = (unsigned*)(ws + WS_CTL);
    for (int u = tid; u < 256; u += NWAVES * 64) ((LAS unsigned*)(lds + MISC_OFF))[u] = 0u;
    __syncthreads();
    XcdBarrier bar; bar.bar = ctl + CW_BAR; bar.x = 0; bar.st = nullptr;
#if !MK_PER_PHASE
    bar = xcd_barrier_post(ctl + CW_BAR, MISC + 8);
#define GRID_BAR() xcd_barrier(bar)
#else
#define GRID_BAR() do { } while (0)
#endif
    const int lo = args.ph_lo, hi = args.ph_hi;
#ifndef PH_MASK
#define PH_MASK 0xffffffffu
#endif
#define PHON(s) ((PH_MASK >> (s)) & 1u)
#ifndef REP_MASK
#define REP_MASK 0u
#endif
#define REPN(s) (((REP_MASK >> (s)) & 1u) ? 2 : 1)
#define IN(k) (lo <= (k) && (k) < hi)
#define SEAM(k) do { if (IN(k) && IN((k) + 1)) GRID_BAR(); } while (0)
#define XB ((bf16_t*)(ws_ + WS_XB))
#define QKV ((bf16_t*)(ws_ + WS_QKV))
#define MIX ((bf16_t*)(ws_ + WS_MIX))
#define HM ((bf16_t*)(ws_ + WS_HM))
#define HEXP ((bf16_t*)(ws_ + WS_HEXP))
#define YEXP ((bf16_t*)(ws_ + WS_QKV))

#define PH_IDS KArgs A = (KArgs)__builtin_amdgcn_kernarg_segment_ptr(); asm volatile("" : "+s"(A)); unsigned char* ws_ = A->ws; (void)ws_; int tid_ = tid; asm volatile("" : "+v"(tid_)); const int lane_ = tid_ & 63; int wave_ = wave; asm volatile("" : "+s"(wave_)); (void)lane_; (void)wave_;
    if (PHON(0) && IN(0)) { PH_IDS phase_prologue(A, lds, gw, NGW, wave_, lane_); } SEAM(0);

    for (int l = 0; l < DEPTH; ++l) {
        const int pb = 1 + l * PH_PER_LAYER; const int li = l >> 1;
        if ((l & 1) == 0) {
            if (PHON(1) && IN(pb + 0)) for (int rep_ = 0; rep_ < REPN(1); ++rep_) { if (rep_) __syncthreads(); PH_IDS pg8::Gemm g{XB, (const bf16_t*)(ws_ + WS_WINAB) + (size_t)li * QKVW * D, T, QKVW, D, nullptr, QKVW}; pg8::StaticOrder S; S.init(T, QKVW, G, bx);
                pg8::EpiBf16<2> E{QKV, QKVW}; pg8::gemm_phase<pg8::EpiBf16<2>, pg8::StaticOrder, false>(lds, g, S, E, tid_); }
            SEAM(pb + 0);
            if (IN(pb + 1)) for (int rep_ = 0; rep_ < REPN(2); ++rep_) {
                if (rep_) __syncthreads();
                PH_IDS
                { const float* rp = A->in[I_RPB] + (size_t)li * 8 * 465; LAS float* rl = (LAS float*)(lds + RPB_OFF);
                  constexpr int NTR = (NA_PEN + 128 + NWAVES * 64 - 1) / (NWAVES * 64); float tv[NTR];
#pragma unroll
                  for (int u = 0; u < NTR; ++u) { const int i = tid_ + u * (NWAVES * 64); int ix = i - NA_PADB; ix = ix < 0 ? 0 : (ix > 8 * 465 - 1 ? 8 * 465 - 1 : ix); tv[u] = rp[ix]; }
#pragma unroll
                  for (int u = 0; u < NTR; ++u) { const int i = tid_ + u * (NWAVES * 64); float v = 0.f;
                      if (i >= NA_PADB && i < NA_PADB + 8 * 465) v = tv[u] * LOG2E;
                      else if (i >= NA_PEN) { const int t = i - NA_PEN - 48; v = (t >= 0 && t <= 15) ? 0.f : -1e30f; }
                      if (i < NA_PEN + 128) rl[i] = v; } }
                __syncthreads();
                phase_key_norms(QKV, (float*)(ws_ + WS_KN), gw, NGW, lane_);
                asm volatile("s_waitcnt vmcnt(0)" ::: "memory"); __syncthreads();
                if (tid_ == 0) { __builtin_amdgcn_fence(__ATOMIC_RELEASE, "agent"); __hip_atomic_fetch_add((unsigned*)(ws_ + WS_CTL) + 3072 + 64 * li, 1u, __ATOMIC_RELAXED, __HIP_MEMORY_SCOPE_AGENT); }
                if (PHON(2)) for (int u = vcu; u < 512; u += G) natten_unit(QKV, MIX, u >> 7, u & 127, lds, wave_, lane_);
                __syncthreads();
            }
            if (PHON(3) && IN(pb + 2)) for (int rep_ = 0; rep_ < REPN(3); ++rep_) {
                if (rep_) __syncthreads();
                PH_IDS
                const float* lq = A->in[I_LAMQK] + (size_t)li * 256;
                const float d1 = wave_sum(lq[lane_] * lq[64 + lane_]), d2 = wave_sum(lq[128 + lane_] * lq[192 + lane_]);
                const float lam_init = (li == 0) ? 0.2f : (float)(0.8 - 0.6 * 0.54881163609402643);
                const float lam = uni_f(__expf(d1) - __expf(d2) + lam_init);
                unsigned* qhead = (unsigned*)(ws_ + WS_CTL) + 2048 + 64 * li;
                constexpr int NCONV = 8;
                const bool conv_first = vcu >= G - NCONV;
                if (conv_first && PHON(10)) { phase_moe_convert(A, l, lds, gw, NGW, wave_, lane_); if (l + 1 < DEPTH) phase_moe_convert(A, l + 1, lds, gw, NGW, wave_, lane_); __syncthreads(); }
                if (tid_ == 0) { unsigned* kc = (unsigned*)(ws_ + WS_CTL) + 3072 + 64 * li; unsigned sp = 0;
                    while (__hip_atomic_load(kc, __ATOMIC_RELAXED, __HIP_MEMORY_SCOPE_AGENT) < (unsigned)G) { __builtin_amdgcn_s_sleep(1); if (++sp > XB_SPIN_CAP) break; }
                    __builtin_amdgcn_fence(__ATOMIC_ACQUIRE, "agent"); }
                __syncthreads();
                unsigned nxt = 0; if (tid_ == 0) nxt = __builtin_amdgcn_atomic_inc32(qhead, 0xffffffffu, __ATOMIC_RELAXED, "agent");
                _Pragma("nounroll") for (;;) {
                    LAS int* qs = (LAS int*)(lds + MISC_OFF + 512);
                    if (tid_ == 0) qs[0] = (int)nxt;
                    __syncthreads();
                    const int u = __builtin_amdgcn_readfirstlane(qs[0]);
                    __syncthreads();
                    if (u >= 1024) break;
                    if (tid_ == 0) nxt = __builtin_amdgcn_atomic_inc32(qhead, 0xffffffffu, __ATOMIC_RELAXED, "agent");
                    const int h = 3 - (u >> 8), b = (u >> 6) & 3, qb = u & 63;
                    const float slope = uni_f(__uint_as_float((unsigned)(127 - 2 * (h + 1)) << 23));
                    diff_attn_unit(QKV, MIX, (const float*)(ws_ + WS_KN), b, h, qb, lam, uni_f(slope * LOG2E), A->in[I_SUBLN] + (size_t)li * 512, 1.0f - lam_init, lds, tid_, wave_, lane_); }
                if (!conv_first && PHON(10)) { __syncthreads(); phase_moe_convert(A, l, lds, gw, NGW, wave_, lane_); if (l + 1 < DEPTH) phase_moe_convert(A, l + 1, lds, gw, NGW, wave_, lane_); __syncthreads(); }
            }
            SEAM(pb + 2);
            if (PHON(4) && IN(pb + 3)) for (int rep_ = 0; rep_ < REPN(4); ++rep_) { if (rep_) __syncthreads(); PH_IDS pg8::Gemm g{MIX, (const bf16_t*)(ws_ + WS_WOUTAB) + (size_t)li * D * D, T, D, D, nullptr, D}; pg8::StaticOrder S; S.init(T, D, G, bx);
                pg8::EpiBf16<0> E{HM, D}; pg8::gemm_phase<pg8::EpiBf16<0>, pg8::StaticOrder, false>(lds, g, S, E, tid_); }
            SEAM(pb + 3);
        } else {
            if (PHON(5) && IN(pb + 0)) for (int rep_ = 0; rep_ < REPN(5); ++rep_) { if (rep_) __syncthreads(); PH_IDS pg8::Gemm g{XB, (const bf16_t*)(ws_ + WS_WINC) + (size_t)li * 2048 * D, T, 2048, D, nullptr, 2048}; pg8::StaticOrder S; S.init(T, 2048, G, bx);
                pg8::EpiBf16<1> E{QKV, 2048}; pg8::gemm_phase<pg8::EpiBf16<1>, pg8::StaticOrder, false>(lds, g, S, E, tid_); }
            SEAM(pb + 0);
            if (PHON(6) && IN(pb + 1)) for (int rep_ = 0; rep_ < REPN(6); ++rep_) { if (rep_) __syncthreads(); PH_IDS for (int u = vcu; u < T / 128; u += G) sgu_unit(A, li, u, lds, tid_, wave_, lane_); }
            SEAM(pb + 1);
            if (PHON(7) && IN(pb + 3)) for (int rep_ = 0; rep_ < REPN(7); ++rep_) { if (rep_) __syncthreads(); PH_IDS pg8::Gemm g{MIX, (const bf16_t*)(ws_ + WS_WOUTC) + (size_t)li * D * D, T, D, D, nullptr, D}; pg8::StaticOrder S; S.init(T, D, G, bx);
                pg8::EpiBf16<0> E{HM, D}; pg8::gemm_phase<pg8::EpiBf16<0>, pg8::StaticOrder, false>(lds, g, S, E, tid_); }
            SEAM(pb + 3);
        }
        if (PHON(8) && IN(pb + 4)) for (int rep_ = 0; rep_ < ((l == 0) ? REPN(8) : 1); ++rep_) { PH_IDS phase_ln_router<false>(A, l, lds, gw, NGW, tid_, lane_);
            asm volatile("s_waitcnt vmcnt(0)" ::: "memory"); __syncthreads();
            if (tid_ == 0) { __builtin_amdgcn_fence(__ATOMIC_RELEASE, "agent"); __hip_atomic_fetch_add((unsigned*)(ws_ + WS_CTL) + 3200 + 64 * l, 1u, __ATOMIC_RELAXED, __HIP_MEMORY_SCOPE_AGENT); } }
        if (IN(pb + 5)) for (int rep_ = 0; rep_ < REPN(9); ++rep_) { if (rep_) __syncthreads(); PH_IDS
            if (PHON(9) && vcu < BATCH * NE) {
                if (tid_ == 0) { unsigned* rc = (unsigned*)(ws_ + WS_CTL) + 3200 + 64 * l; unsigned sp = 0;
                    while (__hip_atomic_load(rc, __ATOMIC_RELAXED, __HIP_MEMORY_SCOPE_AGENT) < (unsigned)G) { __builtin_amdgcn_s_sleep(1); if (++sp > XB_SPIN_CAP) break; }
                    __builtin_amdgcn_fence(__ATOMIC_ACQUIRE, "agent"); }
                __syncthreads();
                for (int u = vcu; u < BATCH * NE; u += G) topk_unit(A, u, lds, tid_, wave_, lane_); }
            __syncthreads(); }
        SEAM(pb + 5);
        if (PHON(11) && IN(pb + 6)) for (int rep_ = 0; rep_ < REPN(11); ++rep_) { if (rep_) __syncthreads(); PH_IDS pg8::Gemm g{XB, (const bf16_t*)(ws_ + WS_WGU + (size_t)(l & 1) * WS_WDELTA), NE * EROWS, NE * 4096, D, (const int*)(ws_ + WS_SELT), 4096}; pg8::XcdExpertOrder S; S.init(EROWS / 256, 4096 / 256, G, bx);
            pg8::EpiSwiGLU E{HEXP}; pg8::gemm_phase<pg8::EpiSwiGLU, pg8::XcdExpertOrder, true>(lds, g, S, E, tid_); }
        SEAM(pb + 6);
        if (PHON(12) && IN(pb + 7)) for (int rep_ = 0; rep_ < REPN(12); ++rep_) { if (rep_) __syncthreads(); PH_IDS pg8::Gemm g{HEXP, (const bf16_t*)(ws_ + WS_WD + (size_t)(l & 1) * WS_WDELTA), NE * EROWS, NE * D, DEXP, nullptr, D}; pg8::XcdExpertOrder S; S.init(EROWS / 256, D / 256, G, bx, 2, 1);
            pg8::EpiDown E{YEXP, (const float*)(ws_ + WS_SELG)}; pg8::gemm_phase<pg8::EpiDown, pg8::XcdExpertOrder, false, true>(lds, g, S, E, tid_); }
        SEAM(pb + 7);
        if (PHON(13) && IN(pb + 8)) for (int rep_ = 0; rep_ < ((l == DEPTH - 1) ? REPN(13) : 1); ++rep_) { PH_IDS phase_combine_ln(A, l, gw, NGW, lane_); }
        SEAM(pb + 8);
    }
#undef IN
#undef SEAM
#undef XB
#undef QKV
#undef MIX
#undef HM
#undef HEXP
#undef YEXP
}

extern "C" void kernel_launch(void* const* d_in, const int* in_sizes, int n_in, void* d_out, int out_size, void* d_ws, size_t ws_size, hipStream_t stream) {
    static int grid = 0;
    if (grid == 0) {
        if (n_in != 20 || out_size != T * D || ws_size < WS_END) { fprintf(stderr, "kernel_launch: unexpected shapes (n_in %d out %d ws %zu, need %zu)\n", n_in, out_size, ws_size, (size_t)WS_END); grid = -1; return; }
        int dev = 0, cus = 0, per_cu = 0;
        if (hipGetDevice(&dev) != hipSuccess || hipDeviceGetAttribute(&cus, hipDeviceAttributeMultiprocessorCount, dev) != hipSuccess) { grid = -1; return; }
        if (hipFuncSetAttribute((const void*)enc_fwd, hipFuncAttributeMaxDynamicSharedMemorySize, LDS_BYTES) != hipSuccess) { fprintf(stderr, "kernel_launch: hipFuncSetAttribute failed\n"); grid = -1; return; }
        if (hipOccupancyMaxActiveBlocksPerMultiprocessor(&per_cu, (const void*)enc_fwd, NWAVES * 64, LDS_BYTES) != hipSuccess || per_cu < 1) fprintf(stderr, "kernel_launch: occupancy query reports %d\n", per_cu);
        (void)hipGetLastError();
        grid = cus;
    }
    if (grid < 0) return;
    if (hipMemsetAsync((char*)d_ws + WS_CTL, 0, CTL_ZERO_BYTES, stream) != hipSuccess) return;
    Args a{};
    for (int i = 0; i < 20; ++i) a.in[i] = (const float*)d_in[i];
    a.out = (float*)d_out; a.ws = (unsigned char*)d_ws;
#if MK_PER_PHASE
    for (int p = 0; p < N_PHASES; ++p) { a.ph_lo = p; a.ph_hi = p + 1; hipLaunchKernelGGL(enc_fwd, dim3(grid), dim3(NWAVES * 64), LDS_BYTES, stream, a); }
#else
    a.ph_lo = 0; a.ph_hi = N_PHASES;
    hipLaunchKernelGGL(enc_fwd, dim3(grid), dim3(NWAVES * 64), LDS_BYTES, stream, a);
#endif
    const hipError_t le = hipPeekAtLastError();
    if (le != hipSuccess) fprintf(stderr, "kernel_launch: launch failed: %s\n", hipGetErrorName(le));
}
```
